# Optimizing an MI355X kernel written in HIP

```python
import math
import jax, jax.numpy as jnp
from jax import lax
import numpy as np

D_MODEL = 1024
BATCH = 8
SEQ = 2048
DEPTH = 1

GLA_HEADS = 4
GLA_DK = D_MODEL // 2
GLA_DV = D_MODEL
GLA_HEAD_DK = GLA_DK // GLA_HEADS
GLA_HEAD_DV = GLA_DV // GLA_HEADS
GLA_GATE_RANK = 16
GLA_GATE_TAU = 16.0
GLA_CHUNK = 64
POOL_WIDTH = D_MODEL
POOL_WINDOWS = (2, 4, 8, 16)
POOL_GROUPS = len(POOL_WINDOWS)
POOL_GROUP_DIM = POOL_WIDTH // POOL_GROUPS
NORM_EPS = 1e-5
DEEPNORM_ALPHA = (2.0 * DEPTH) ** 0.25
DEEPNORM_BETA = (8.0 * DEPTH) ** -0.25

SPLIT_SIZES = (GLA_DK, GLA_DK, GLA_DV, GLA_DV, GLA_GATE_RANK,
               POOL_WIDTH, POOL_WIDTH, D_MODEL, D_MODEL)
D_IN = int(sum(SPLIT_SIZES))
SPLIT_POINTS = tuple(int(p) for p in np.cumsum(SPLIT_SIZES)[:-1])

kernel_name = "hybrid_gla_pool_gated_deepnorm"


def gla_chunked(q, k, v, log_a):
    B, S, H, dk = q.shape
    dv = v.shape[-1]
    n = S // GLA_CHUNK

    def to_chunks(t):
        return t.reshape(B, n, GLA_CHUNK, H, t.shape[-1]).transpose(1, 0, 3, 2, 4)

    qc, kc, vc, ac = to_chunks(q), to_chunks(k), to_chunks(v), to_chunks(log_a)
    causal = jnp.tril(jnp.ones((GLA_CHUNK, GLA_CHUNK), dtype=bool))[None, None, :, :, None]

    def step(state, inp):
        qi, ki, vi, ai = inp
        qi = qi.astype(jnp.float32)
        ki = ki.astype(jnp.float32)
        vi = vi.astype(jnp.float32)
        b = jnp.cumsum(ai.astype(jnp.float32), axis=2)
        o_inter = jnp.einsum('bhck,bhkv->bhcv', qi * jnp.exp(b), state)
        diff = b[:, :, :, None, :] - b[:, :, None, :, :]
        decay = jnp.exp(jnp.where(causal, diff, -jnp.inf))
        scores = jnp.einsum('bhik,bhjk,bhijk->bhij', qi, ki, decay)
        o_intra = jnp.einsum('bhij,bhjv->bhiv', scores, vi)
        b_last = b[:, :, -1:, :]
        k_dec = ki * jnp.exp(b_last - b)
        new_state = (jnp.exp(b_last[:, :, 0, :])[..., None] * state
                     + jnp.einsum('bhck,bhcv->bhkv', k_dec, vi))
        return new_state, o_inter + o_intra

    state0 = jnp.zeros((B, H, dk, dv), jnp.float32)
    _, o = lax.scan(step, state0, (qc, kc, vc, ac))
    return o.transpose(1, 0, 3, 2, 4).reshape(B, S, H, dv)


def causal_multiscale_pool(u):
    B, S, G, Cg = u.shape
    u32 = u.astype(jnp.float32)
    cs = jnp.cumsum(u32, axis=1)
    cs = jnp.concatenate([jnp.zeros_like(cs[:, :1]), cs], axis=1)
    t = jnp.arange(S)
    win = jnp.array(POOL_WINDOWS, dtype=jnp.int32)
    start = jnp.maximum(t[:, None] + 1 - win[None, :], 0)
    lower = cs[:, start, jnp.arange(G)[None, :]]
    count = jnp.minimum(t[:, None] + 1, win[None, :]).astype(jnp.float32)
    pooled = (cs[:, 1:] - lower) / count[None, :, :, None]
    return pooled - u32


def rms_norm_heads(o, w):
    o32 = o.astype(jnp.float32)
    o32 = o32 * lax.rsqrt(jnp.mean(jnp.square(o32), axis=-1, keepdims=True) + NORM_EPS)
    B, S = o.shape[:2]
    return o32.reshape(B, S, -1) * w


def layer_norm(r, w, b):
    r32 = r.astype(jnp.float32)
    mu = jnp.mean(r32, axis=-1, keepdims=True)
    var = jnp.mean(jnp.square(r32 - mu), axis=-1, keepdims=True)
    return (r32 - mu) * lax.rsqrt(var + NORM_EPS) * w + b


def hybrid_layer(x, w_in, w_gate_up, b_gate, gn_w, pool_w, pool_b, pool_scale,
                 w_a, w_b, w_o, ln_w, ln_b):
    B, S, _ = x.shape
    h = jnp.einsum('bsd,de->bse', x, w_in)
    q, k, v, g, a_low, u, z, gate_a, gate_b = jnp.split(h, SPLIT_POINTS, axis=-1)

    log_a = jax.nn.log_sigmoid(
        (jnp.einsum('bsr,rk->bsk', a_low, w_gate_up) + b_gate).astype(jnp.float32)) / GLA_GATE_TAU
    q = q.reshape(B, S, GLA_HEADS, GLA_HEAD_DK) * (GLA_HEAD_DK ** -0.5)
    k = k.reshape(B, S, GLA_HEADS, GLA_HEAD_DK)
    v = v.reshape(B, S, GLA_HEADS, GLA_HEAD_DV)
    log_a = log_a.reshape(B, S, GLA_HEADS, GLA_HEAD_DK)
    o = gla_chunked(q, k, v, log_a)
    y_a = rms_norm_heads(o, gn_w) * jax.nn.silu(g.astype(jnp.float32))

    p = causal_multiscale_pool(u.reshape(B, S, POOL_GROUPS, POOL_GROUP_DIM))
    p = jnp.einsum('bsgc,gcd->bsgd', p, pool_w).reshape(B, S, POOL_WIDTH) + pool_b
    y_b = p * pool_scale * jax.nn.silu(z.astype(jnp.float32))

    merged = (jax.nn.sigmoid(gate_a.astype(jnp.float32)) * jnp.einsum('bse,ed->bsd', y_a, w_a)
              + jax.nn.sigmoid(gate_b.astype(jnp.float32)) * jnp.einsum('bse,ed->bsd', y_b, w_b))
    out = jnp.einsum('bsd,de->bse', merged, w_o)

    return layer_norm(DEEPNORM_ALPHA * x.astype(jnp.float32) + out, ln_w, ln_b).astype(x.dtype)


def setup_inputs(seed: int = 0) -> dict:
    key = jax.random.key(seed)
    ks = jax.random.split(key, 14)
    L = DEPTH
    f32 = jnp.float32
    x = jax.random.normal(ks[0], (BATCH, SEQ, D_MODEL), f32)
    w_in = jax.random.normal(ks[1], (L, D_MODEL, D_IN), f32) * D_MODEL ** -0.5
    w_gate_up = jax.random.normal(ks[2], (L, GLA_GATE_RANK, GLA_DK), f32) * GLA_GATE_RANK ** -0.5
    b_gate = 0.1 * jax.random.normal(ks[3], (L, GLA_DK), f32)
    gn_w = 1.0 + 0.02 * jax.random.normal(ks[4], (L, GLA_DV), f32)
    pool_w = jax.random.normal(ks[5], (L, POOL_GROUPS, POOL_GROUP_DIM, POOL_GROUP_DIM), f32) * POOL_GROUP_DIM ** -0.5
    pool_b = 0.02 * jax.random.normal(ks[6], (L, POOL_WIDTH), f32)
    pool_scale = 1.0 + 0.02 * jax.random.normal(ks[7], (L, POOL_WIDTH), f32)
    w_a = jax.random.normal(ks[8], (L, GLA_DV, D_MODEL), f32) * (GLA_DV ** -0.5) * DEEPNORM_BETA
    w_b = jax.random.normal(ks[9], (L, POOL_WIDTH, D_MODEL), f32) * (POOL_WIDTH ** -0.5) * DEEPNORM_BETA
    w_o = jax.random.normal(ks[10], (L, D_MODEL, D_MODEL), f32) * (D_MODEL ** -0.5) * DEEPNORM_BETA
    ln_w = 1.0 + 0.02 * jax.random.normal(ks[11], (L, D_MODEL), f32)
    ln_b = 0.02 * jax.random.normal(ks[12], (L, D_MODEL), f32)
    return {"x": x, "w_in": w_in, "w_gate_up": w_gate_up, "b_gate": b_gate, "gn_w": gn_w,
            "pool_w": pool_w, "pool_b": pool_b, "pool_scale": pool_scale,
            "w_a": w_a, "w_b": w_b, "w_o": w_o, "ln_w": ln_w, "ln_b": ln_b}


def reference(x, w_in, w_gate_up, b_gate, gn_w, pool_w, pool_b, pool_scale,
              w_a, w_b, w_o, ln_w, ln_b):
    for l in range(DEPTH):
        x = hybrid_layer(x, w_in[l], w_gate_up[l], b_gate[l], gn_w[l], pool_w[l], pool_b[l],
                         pool_scale[l], w_a[l], w_b[l], w_o[l], ln_w[l], ln_b[l])
    return x
```

```cpp
#include <hip/hip_runtime.h>
#include <cstdio>
#include <cstdint>

constexpr int D = 1024, BATCH = 8, SEQ = 2048;
constexpr int DK = 512, DV = 1024, HDK = 128, HDV = 256, RANK = 16;
constexpr int DIN = 7184;
constexpr int C_Q = 0, C_K = 512, C_V = 1024, C_G = 2048, C_AL = 3072, C_U = 3088, C_Z = 4112, C_GA = 5136, C_GB = 6160;
constexpr float EPS = 1e-5f;

__global__ void __launch_bounds__(256) gemm_f32(const float* __restrict__ A, int lda, const float* __restrict__ B, int ldb, float* __restrict__ C, int ldc, int M, int N, int K) {
    __shared__ float As[16][64 + 4];
    __shared__ float Bs[16][64 + 4];
    const int tid = threadIdx.x, tx = tid & 15, ty = tid >> 4;
    const int m0 = blockIdx.y * 64, n0 = blockIdx.x * 64;
    float acc[4][4];
#pragma unroll
    for (int i = 0; i < 4; ++i)
#pragma unroll
        for (int j = 0; j < 4; ++j) acc[i][j] = 0.f;
    for (int k0 = 0; k0 < K; k0 += 16) {
        {
            const int r = tid >> 2, c = (tid & 3) * 4;
            const float4 v = *(const float4*)(A + (size_t)(m0 + r) * lda + k0 + c);
            As[c + 0][r] = v.x; As[c + 1][r] = v.y; As[c + 2][r] = v.z; As[c + 3][r] = v.w;
        }
        {
            const int r = tid >> 4, c = (tid & 15) * 4;
#pragma unroll
            for (int j = 0; j < 4; ++j) { const int n = n0 + c + j; Bs[r][c + j] = (n < N) ? B[(size_t)(k0 + r) * ldb + n] : 0.f; }
        }
        __syncthreads();
#pragma unroll
        for (int kk = 0; kk < 16; ++kk) {
            float a[4], b[4];
#pragma unroll
            for (int i = 0; i < 4; ++i) a[i] = As[kk][ty * 4 + i];
#pragma unroll
            for (int j = 0; j < 4; ++j) b[j] = Bs[kk][tx * 4 + j];
#pragma unroll
            for (int i = 0; i < 4; ++i)
#pragma unroll
                for (int j = 0; j < 4; ++j) acc[i][j] = fmaf(a[i], b[j], acc[i][j]);
        }
        __syncthreads();
    }
#pragma unroll
    for (int i = 0; i < 4; ++i)
#pragma unroll
        for (int j = 0; j < 4; ++j) { const int n = n0 + tx * 4 + j; if (n < N) C[(size_t)(m0 + ty * 4 + i) * ldc + n] = acc[i][j]; }
}

__device__ __forceinline__ float sigmoidf_(float x) { return 1.f / (1.f + expf(-x)); }
__device__ __forceinline__ float siluf_(float x) { return x * sigmoidf_(x); }
__device__ __forceinline__ float logsigmoidf_(float x) { return fminf(x, 0.f) - log1pf(expf(-fabsf(x))); }

__global__ void k_loga(const float* __restrict__ H, const float* __restrict__ Wg, const float* __restrict__ bg, float* __restrict__ la) {
    const int idx = blockIdx.x * blockDim.x + threadIdx.x; if (idx >= SEQ * DK) return;
    const int t = idx / DK, k = idx % DK;
    float s = bg[k];
    for (int r = 0; r < RANK; ++r) s = fmaf(H[(size_t)t * DIN + C_AL + r], Wg[r * DK + k], s);
    la[idx] = logsigmoidf_(s) * (1.f / 16.f);
}

__global__ void __launch_bounds__(256) k_gla_seq(const float* __restrict__ H, const float* __restrict__ la, float* __restrict__ O) {
    __shared__ float sq[128], sk[128], sa[128];
    const int h = blockIdx.x, col = threadIdx.x;
    float S[128];
#pragma unroll
    for (int k = 0; k < 128; ++k) S[k] = 0.f;
    const float qs = 0.08838834764831845f;
    for (int t = 0; t < SEQ; ++t) {
        __syncthreads();
        if (col < 128) { sq[col] = H[(size_t)t * DIN + C_Q + h * 128 + col] * qs; sk[col] = H[(size_t)t * DIN + C_K + h * 128 + col]; sa[col] = expf(la[(size_t)t * DK + h * 128 + col]); }
        __syncthreads();
        const float v = H[(size_t)t * DIN + C_V + h * 256 + col];
        float o = 0.f;
#pragma unroll
        for (int k = 0; k < 128; ++k) { S[k] = fmaf(sa[k], S[k], sk[k] * v); o = fmaf(sq[k], S[k], o); }
        O[(size_t)t * DV + h * 256 + col] = o;
    }
}

__global__ void __launch_bounds__(256) k_ya(const float* __restrict__ O, const float* __restrict__ H, const float* __restrict__ gnw, float* __restrict__ YA) {
    __shared__ float red[4];
    const int t = blockIdx.x, c = threadIdx.x;
    for (int h = 0; h < 4; ++h) {
        const float o = O[(size_t)t * DV + h * 256 + c];
        float s = o * o;
        for (int off = 32; off >= 1; off >>= 1) s += __shfl_xor(s, off);
        __syncthreads();
        if ((c & 63) == 0) red[c >> 6] = s;
        __syncthreads();
        const float tot = red[0] + red[1] + red[2] + red[3];
        const float r = rsqrtf(tot * (1.f / 256.f) + EPS);
        const float g = H[(size_t)t * DIN + C_G + h * 256 + c];
        YA[(size_t)t * DV + h * 256 + c] = o * r * gnw[h * 256 + c] * siluf_(g);
    }
}

__global__ void k_pool(const float* __restrict__ H, float* __restrict__ P) {
    const int idx = blockIdx.x * blockDim.x + threadIdx.x; if (idx >= SEQ * 1024) return;
    const int t = idx / 1024, c = idx % 1024, g = c >> 8;
    const int w = 2 << g;
    const int cnt = (t + 1 < w) ? t + 1 : w;
    float s = 0.f;
    for (int j = t - cnt + 1; j <= t; ++j) s += H[(size_t)j * DIN + C_U + c];
    P[idx] = s / (float)cnt - H[(size_t)t * DIN + C_U + c];
}

__global__ void k_yb(const float* __restrict__ PB, const float* __restrict__ H, const float* __restrict__ pb, const float* __restrict__ ps, float* __restrict__ YB) {
    const int idx = blockIdx.x * blockDim.x + threadIdx.x; if (idx >= SEQ * 1024) return;
    const int t = idx / 1024, c = idx % 1024;
    YB[idx] = (PB[idx] + pb[c]) * ps[c] * siluf_(H[(size_t)t * DIN + C_Z + c]);
}

__global__ void k_merge(const float* __restrict__ MA, const float* __restrict__ MB, const float* __restrict__ H, float* __restrict__ MG) {
    const int idx = blockIdx.x * blockDim.x + threadIdx.x; if (idx >= SEQ * 1024) return;
    const int t = idx / 1024, c = idx % 1024;
    MG[idx] = sigmoidf_(H[(size_t)t * DIN + C_GA + c]) * MA[idx] + sigmoidf_(H[(size_t)t * DIN + C_GB + c]) * MB[idx];
}

__global__ void __launch_bounds__(256) k_ln(const float* __restrict__ X, const float* __restrict__ R, const float* __restrict__ w, const float* __restrict__ b, float* __restrict__ OUT) {
    __shared__ float red[4];
    const int t = blockIdx.x, c = threadIdx.x;
    const float alpha = 1.189207115002721f;
    float v[4]; float s = 0.f;
#pragma unroll
    for (int j = 0; j < 4; ++j) { v[j] = alpha * X[(size_t)t * D + c + 256 * j] + R[(size_t)t * D + c + 256 * j]; s += v[j]; }
    for (int off = 32; off >= 1; off >>= 1) s += __shfl_xor(s, off);
    if ((c & 63) == 0) red[c >> 6] = s;
    __syncthreads();
    const float mean = (red[0] + red[1] + red[2] + red[3]) * (1.f / D);
    __syncthreads();
    float q = 0.f;
#pragma unroll
    for (int j = 0; j < 4; ++j) { v[j] -= mean; q += v[j] * v[j]; }
    for (int off = 32; off >= 1; off >>= 1) q += __shfl_xor(q, off);
    if ((c & 63) == 0) red[c >> 6] = q;
    __syncthreads();
    const float rstd = rsqrtf((red[0] + red[1] + red[2] + red[3]) * (1.f / D) + EPS);
#pragma unroll
    for (int j = 0; j < 4; ++j) OUT[(size_t)t * D + c + 256 * j] = v[j] * rstd * w[c + 256 * j] + b[c + 256 * j];
}

extern "C" void kernel_launch(void* const* d_in, const int* in_sizes, int n_in, void* d_out, int out_size, void* d_ws, size_t ws_size, hipStream_t stream) {
    const float* x = (const float*)d_in[0]; const float* w_in = (const float*)d_in[1]; const float* wg = (const float*)d_in[2]; const float* bg = (const float*)d_in[3];
    const float* gnw = (const float*)d_in[4]; const float* pw = (const float*)d_in[5]; const float* pb = (const float*)d_in[6]; const float* ps = (const float*)d_in[7];
    const float* w_a = (const float*)d_in[8]; const float* w_b = (const float*)d_in[9]; const float* w_o = (const float*)d_in[10]; const float* lnw = (const float*)d_in[11]; const float* lnb = (const float*)d_in[12];
    float* out = (float*)d_out;
    float* ws = (float*)d_ws;
    const size_t T1 = (size_t)SEQ * 1024;
    float* H = ws;
    float* LA = H + (size_t)SEQ * DIN;
    float* O = LA + (size_t)SEQ * DK;
    float* YA = O + T1; float* P = YA + T1; float* PB = P + T1; float* YB = PB + T1; float* MA = YB + T1; float* MB = MA + T1; float* MG = MB + T1; float* R = MG + T1;
    if ((size_t)((R + T1) - ws) * 4 > ws_size) { fprintf(stderr, "ws too small: %zu\n", ws_size); return; }
    const int EW = (int)((T1 + 255) / 256);
    for (int b = 0; b < BATCH; ++b) {
        const float* xb = x + (size_t)b * SEQ * D;
        gemm_f32<<<dim3((DIN + 63) / 64, SEQ / 64), 256, 0, stream>>>(xb, D, w_in, DIN, H, DIN, SEQ, DIN, D);
        k_loga<<<(SEQ * DK + 255) / 256, 256, 0, stream>>>(H, wg, bg, LA);
        k_gla_seq<<<4, 256, 0, stream>>>(H, LA, O);
        k_ya<<<SEQ, 256, 0, stream>>>(O, H, gnw, YA);
        k_pool<<<EW, 256, 0, stream>>>(H, P);
        for (int g = 0; g < 4; ++g)
            gemm_f32<<<dim3(4, SEQ / 64), 256, 0, stream>>>(P + g * 256, 1024, pw + (size_t)g * 256 * 256, 256, PB + g * 256, 1024, SEQ, 256, 256);
        k_yb<<<EW, 256, 0, stream>>>(PB, H, pb, ps, YB);
        gemm_f32<<<dim3(16, SEQ / 64), 256, 0, stream>>>(YA, 1024, w_a, 1024, MA, 1024, SEQ, 1024, 1024);
        gemm_f32<<<dim3(16, SEQ / 64), 256, 0, stream>>>(YB, 1024, w_b, 1024, MB, 1024, SEQ, 1024, 1024);
        k_merge<<<EW, 256, 0, stream>>>(MA, MB, H, MG);
        gemm_f32<<<dim3(16, SEQ / 64), 256, 0, stream>>>(MG, 1024, w_o, 1024, R, 1024, SEQ, 1024, 1024);
        k_ln<<<SEQ, 256, 0, stream>>>(xb, R, lnw, lnb, out + (size_t)b * SEQ * D);
    }
}
```

```cpp
#include <hip/hip_runtime.h>
#include <cstdio>
#include <cstdint>
namespace pg8 {
#define PG8_LAS __attribute__((address_space(3)))
typedef unsigned short bf16_t;
typedef short bf16x8 __attribute__((ext_vector_type(8)));
typedef float f32x4 __attribute__((ext_vector_type(4)));
typedef unsigned u32x4 __attribute__((ext_vector_type(4)));
constexpr int BM = 256, BK = 64, HALF = 128, HTB = HALF * BK * 2  , STAGE_BYTES = 8 * HTB, NXCD = 8, WGM = 8;

__host__ __device__ __forceinline__ int lds_byte(int r, int c) { const int st = (r >> 4) * 2 + (c >> 5), rr = r & 15, cc = c & 31, ob = rr * 64 + cc * 2; return st * 1024 + (ob ^ (((ob >> 9) & 1) << 5)); }
__host__ __device__ __forceinline__ void stage_rc(int b, int& R, int& C) { const int st = b / 1024, sb = b % 1024, swz = sb ^ (((sb >> 9) & 1) << 5); R = (st >> 1) * 16 + swz / 64; C = (st & 1) * 32 + (swz % 64) / 2; }
__host__ __device__ __forceinline__ int perm32(int rho) { const int n = rho >> 4, i = rho & 15; return 8 * (i >> 2) + 4 * n + (i & 3); }

struct Unit { int pm, pn; };
struct Gemm { const bf16_t* A; const bf16_t* Bt; int K, lda, ldb, a_pn_cols; };

struct StaticOrder {
    int nM, nN, nwg, G, c;
    __host__ __device__ void init(int M, int N, int G_, int c_) { nM = M / BM; nN = N / BM; nwg = nM * nN; G = G_; c = c_; }
    __host__ __device__ bool next(int i, Unit& u) const {
        const long L = (long)i * G + c; if (L >= nwg) return false;
        int wgid = (int)L; { const int q = nwg / NXCD, r = nwg % NXCD, xcd = wgid % NXCD, off = wgid / NXCD; wgid = (xcd < r ? xcd * (q + 1) : r * (q + 1) + (xcd - r) * q) + off; }
        const int nig = WGM * nN, gid = wgid / nig, fm = gid * WGM, gsz = (nM - fm) < WGM ? (nM - fm) : WGM;
        u.pm = fm + ((wgid % nig) % gsz); u.pn = (wgid % nig) / gsz; return true;
    }
    __device__ __forceinline__ void a_ready(const Unit&) const {}
    __device__ __forceinline__ void done(const Unit&) const {}
};

__device__ __forceinline__ unsigned cvt_pk_bf16(float lo, float hi) { unsigned r; asm volatile("v_cvt_pk_bf16_f32 %0, %1, %2" : "=v"(r) : "v"(lo), "v"(hi)); return r; }
typedef float f32x2 __attribute__((ext_vector_type(2)));
__device__ __forceinline__ f32x2 gelu_pk(f32x2 v) {
    const f32x2 av = __builtin_elementwise_abs(v), d = av * 0.2316418882f + 1.0f;
    f32x2 t; t.x = __builtin_amdgcn_rcpf(d.x); t.y = __builtin_amdgcn_rcpf(d.y);
    f32x2 q = t * 0.5307027145f + (-0.7265760135f); q = q * t + 0.7107068705f; q = q * t + (-0.142248368f); q = q * t + 0.127414796f; q = q * t;
    const f32x2 s = (v * v) * (-0.72134752044f);
    f32x2 e; e.x = __builtin_amdgcn_exp2f(s.x); e.y = __builtin_amdgcn_exp2f(s.y);
    const f32x2 m = v * (q * e), r = v - m;
    f32x2 o; o.x = v.x < 0.f ? m.x : r.x; o.y = v.y < 0.f ? m.y : r.y; return o;
}

template <int ACT  > struct EpiBf16 {
    static constexpr bool PERM = true, AFTER_DRAIN = false, HAS_MID = false; static_assert(ACT == 0 || ACT == 1, "EpiBf16: ACT is 0 (none) or 1 (gelu_pk)");
    bf16_t* O; int ldc; const float* bias; int split_cols; size_t split_stride; float scale0;
    __device__ __forceinline__ void operator()(const f32x4 (&acc)[2][2][4][2], const Unit& u, int wr, int wc, int fr, int fq) const {
        const int row0 = u.pm * BM + wr * 64 + fr; int colt = u.pn * BM; bf16_t* base = O;
        float sc = 1.f; if (split_cols) { const int t = colt / split_cols; base += (size_t)t * split_stride; colt -= t * split_cols; if (t == 0) sc = scale0; }
        const int col0 = colt + wc * 32 + 8 * fq, bcol0 = u.pn * BM + wc * 32 + 8 * fq;
        f32x4 bv[2][2];
#pragma unroll
        for (int bj = 0; bj < 2; ++bj)
#pragma unroll
            for (int n = 0; n < 2; ++n) bv[bj][n] = bias ? *(const f32x4*)(bias + bcol0 + bj * HALF + 4 * n) : (f32x4){0.f, 0.f, 0.f, 0.f};
#pragma unroll
        for (int ai = 0; ai < 2; ++ai)
#pragma unroll
            for (int m = 0; m < 4; ++m) { bf16_t* rowp = base + (size_t)(row0 + ai * HALF + m * 16) * ldc + col0;
#pragma unroll
                for (int bj = 0; bj < 2; ++bj) { f32x4 v0 = acc[ai][bj][m][0] + bv[bj][0], v1 = acc[ai][bj][m][1] + bv[bj][1];
                    if (ACT == 1) { f32x2 a = gelu_pk((f32x2){v0[0], v0[1]}), b = gelu_pk((f32x2){v0[2], v0[3]}), c = gelu_pk((f32x2){v1[0], v1[1]}), d = gelu_pk((f32x2){v1[2], v1[3]});
                        v0 = (f32x4){a.x, a.y, b.x, b.y}; v1 = (f32x4){c.x, c.y, d.x, d.y}; }
                    v0 = v0 * sc; v1 = v1 * sc; u32x4 w; w.x = cvt_pk_bf16(v0[0], v0[1]); w.y = cvt_pk_bf16(v0[2], v0[3]); w.z = cvt_pk_bf16(v1[0], v1[1]); w.w = cvt_pk_bf16(v1[2], v1[3]);
                    *(u32x4*)(rowp + bj * HALF) = w; } }
    }
};

struct PanelStats {
    unsigned* xbuf;
    unsigned* cnt;
    unsigned* tmo;
    int ntn; float eps;
    unsigned code;
    __device__ __forceinline__ bool run(const f32x4 (&v)[2][2][4][2], const Unit& u, int wr, int wc, int fr, int fq, PG8_LAS unsigned char* lds, int wid, int lane) const {
        typedef float f32x2v __attribute__((ext_vector_type(2)));
        PG8_LAS f32x2v* P = (PG8_LAS f32x2v*)lds;
        PG8_LAS f32x2v* S = (PG8_LAS f32x2v*)(lds + 8192);
        PG8_LAS unsigned* flag = (PG8_LAS unsigned*)(lds + 8192 + 2048);
#pragma unroll
        for (int ai = 0; ai < 2; ++ai)
#pragma unroll
            for (int m = 0; m < 4; ++m) {
                float s = 0.f;
#pragma unroll
                for (int bj = 0; bj < 2; ++bj)
#pragma unroll
                    for (int n = 0; n < 2; ++n) { const f32x4 x = v[ai][bj][m][n]; s += (x[0] + x[1]) + (x[2] + x[3]); }
                s += __shfl_xor(s, 16); s += __shfl_xor(s, 32);
                const float mw = s * (1.0f / 64.0f); float q = 0.f;
#pragma unroll
                for (int bj = 0; bj < 2; ++bj)
#pragma unroll
                    for (int n = 0; n < 2; ++n) { const f32x4 d = v[ai][bj][m][n] - mw; q += (d[0] * d[0] + d[1] * d[1]) + (d[2] * d[2] + d[3] * d[3]); }
                q += __shfl_xor(q, 16); q += __shfl_xor(q, 32);
                if (fq == 0) P[(ai * HALF + wr * 64 + m * 16 + fr) * 4 + wc] = (f32x2v){mw, q};
            }
        asm volatile("s_waitcnt lgkmcnt(0)" ::: "memory"); __builtin_amdgcn_s_barrier(); asm volatile("" ::: "memory");
#if defined(BROKEN_EXCHANGE_NO_WAIT)
#warning BROKEN CONTROL BUILD: the row-statistics exchange does not wait; results are wrong by design
        if (blockIdx.x >= 64) { const long long t0_ = clock64(); while (clock64() - t0_ < 60000) __builtin_amdgcn_s_sleep(8); }
#endif
        const int row = wid * 32 + (lane & 31);
        if (lane < 32) {
            const f32x2v a = P[row * 4 + 0], b = P[row * 4 + 1], c = P[row * 4 + 2], d = P[row * 4 + 3];
            const float mt = (a.x + b.x + c.x + d.x) * 0.25f;
            const float da = a.x - mt, db = b.x - mt, dc = c.x - mt, dd = d.x - mt;
            const float m2 = (a.y + b.y) + (c.y + d.y) + 64.0f * ((da * da + db * db) + (dc * dc + dd * dd));
            unsigned long long* slot = (unsigned long long*)xbuf + ((size_t)(u.pm * BM + row) * 4 + u.pn);
            __hip_atomic_store(slot, ((unsigned long long)__float_as_uint(m2) << 32) | __float_as_uint(mt), __ATOMIC_RELAXED, __HIP_MEMORY_SCOPE_AGENT);
        }
        asm volatile("s_waitcnt vmcnt(0)" ::: "memory");
        if (lane == 0) __hip_atomic_fetch_add(cnt + 64 * u.pm, 1u, __ATOMIC_RELAXED, __HIP_MEMORY_SCOPE_AGENT);
        if (wid == 0) {
            bool dead = false; const unsigned long long t0 = __builtin_amdgcn_s_memrealtime(); const unsigned want = 8u * (unsigned)ntn;
            for (;;) {
#if defined(BROKEN_EXCHANGE_NO_WAIT)
                break;
#endif
                if ((unsigned)__builtin_amdgcn_readfirstlane(__hip_atomic_load(cnt + 64 * u.pm, __ATOMIC_RELAXED, __HIP_MEMORY_SCOPE_AGENT)) >= want) break;
                if (__builtin_amdgcn_s_memrealtime() - t0 > 2000000ull) {
                    if (lane == 0) { unsigned expect = 0u; __hip_atomic_compare_exchange_strong(tmo + 1, &expect, code | (unsigned)(u.pm & 0xff), __ATOMIC_RELAXED, __ATOMIC_RELAXED, __HIP_MEMORY_SCOPE_AGENT);
                                     __hip_atomic_store(tmo, 1u, __ATOMIC_RELAXED, __HIP_MEMORY_SCOPE_AGENT); }
                    dead = true; break; }
                __builtin_amdgcn_s_sleep(2);
            }
            __builtin_amdgcn_fence(__ATOMIC_ACQUIRE, "agent");
            if (lane == 0) flag[0] = dead ? 1u : 0u;
        }
        asm volatile("s_waitcnt vmcnt(0) lgkmcnt(0)" ::: "memory"); __builtin_amdgcn_s_barrier(); asm volatile("" ::: "memory");
        const bool bad = flag[0] != 0u;
        if (lane < 32) {
            const unsigned long long* slot = (const unsigned long long*)xbuf + (size_t)(u.pm * BM + row) * 4; float mt[4], m2[4]; float ms = 0.f;
#pragma unroll
            for (int t = 0; t < 4; ++t) { if (t < ntn) { const unsigned long long w = __hip_atomic_load(slot + t, __ATOMIC_RELAXED, __HIP_MEMORY_SCOPE_AGENT); mt[t] = __uint_as_float((unsigned)w); m2[t] = __uint_as_float((unsigned)(w >> 32)); } else { mt[t] = 0.f; m2[t] = 0.f; } ms += mt[t]; }
            const float mean = ms / (float)ntn; float q = 0.f;
#pragma unroll
            for (int t = 0; t < 4; ++t) if (t < ntn) { const float dm = mt[t] - mean; q += m2[t] + 256.0f * dm * dm; }
            S[row] = (f32x2v){mean, 1.0f / sqrtf(q / (256.0f * (float)ntn) + eps)};
        }
        asm volatile("s_waitcnt lgkmcnt(0)" ::: "memory"); __builtin_amdgcn_s_barrier(); asm volatile("" ::: "memory");
        return bad;
    }
};
struct EpiLnRes {
    static constexpr bool PERM = false, AFTER_DRAIN = true, HAS_MID = false;
    const float* base; float* out; int ldc; const float* bias; PanelStats st; unsigned poison;
    __device__ __forceinline__ void fused(f32x4 (&acc)[2][2][4][2], const Unit& u, int wr, int wc, int fr, int fq, PG8_LAS unsigned char* lds, int wid, int lane) const {
        typedef float f32x2v __attribute__((ext_vector_type(2)));
        const PG8_LAS f32x2v* S = (const PG8_LAS f32x2v*)(lds + 8192);
        const int col0 = u.pn * BM + wc * 32 + 4 * fq;
#pragma unroll
        for (int bj = 0; bj < 2; ++bj)
#pragma unroll
            for (int n = 0; n < 2; ++n) { const f32x4 bv = bias ? *(const f32x4*)(bias + col0 + bj * HALF + n * 16) : (f32x4){0.f, 0.f, 0.f, 0.f};
#pragma unroll
                for (int ai = 0; ai < 2; ++ai)
#pragma unroll
                    for (int m = 0; m < 4; ++m) acc[ai][bj][m][n] += bv; }
        f32x4 pre[4][2][2];
#pragma unroll
        for (int m = 0; m < 4; ++m) { const size_t off = (size_t)(u.pm * BM + wr * 64 + m * 16 + fr) * ldc + col0;
#pragma unroll
            for (int bj = 0; bj < 2; ++bj)
#pragma unroll
                for (int n = 0; n < 2; ++n) pre[m][bj][n] = *(const f32x4*)(base + off + bj * HALF + n * 16); }
        const bool bad = st.run(acc, u, wr, wc, fr, fq, lds, wid, lane) || poison != 0u;
        const float qnan = __builtin_nanf("");
#pragma unroll
        for (int ai = 0; ai < 2; ++ai)
#pragma unroll
            for (int m = 0; m < 4; ++m) { const int r = ai * HALF + wr * 64 + m * 16 + fr; const f32x2v sr = S[r]; const size_t off = (size_t)(u.pm * BM + r) * ldc + col0;
#pragma unroll
                for (int bj = 0; bj < 2; ++bj)
#pragma unroll
                    for (int n = 0; n < 2; ++n) { const f32x4 bs = ai == 0 ? pre[m][bj][n] : *(const f32x4*)(base + off + bj * HALF + n * 16); f32x4 o = bs + (acc[ai][bj][m][n] - sr.x) * sr.y;
                        if (bad) o = (f32x4){qnan, qnan, qnan, qnan}; *(f32x4*)(out + off + bj * HALF + n * 16) = o; }
                if (m & 1) asm volatile("" ::: "memory"); }
    }
};
struct EpiLnResLn {
    static constexpr bool PERM = false, AFTER_DRAIN = true, HAS_MID = false;
    const float* base; float* out; bf16_t* xn; int ldc; const float* bias; PanelStats st1, st2; unsigned poison;
    __device__ __forceinline__ void fused(f32x4 (&acc)[2][2][4][2], const Unit& u, int wr, int wc, int fr, int fq, PG8_LAS unsigned char* lds, int wid, int lane) const {
        typedef float f32x2v __attribute__((ext_vector_type(2))); typedef unsigned u32x2v __attribute__((ext_vector_type(2)));
        const PG8_LAS f32x2v* S = (const PG8_LAS f32x2v*)(lds + 8192);
        const int col0 = u.pn * BM + wc * 32 + 4 * fq;
#pragma unroll
        for (int bj = 0; bj < 2; ++bj)
#pragma unroll
            for (int n = 0; n < 2; ++n) { const f32x4 bv = bias ? *(const f32x4*)(bias + col0 + bj * HALF + n * 16) : (f32x4){0.f, 0.f, 0.f, 0.f};
#pragma unroll
                for (int ai = 0; ai < 2; ++ai)
#pragma unroll
                    for (int m = 0; m < 4; ++m) acc[ai][bj][m][n] += bv; }
        bool bad = st1.run(acc, u, wr, wc, fr, fq, lds, wid, lane) || poison != 0u;
        const float qnan = __builtin_nanf("");
#pragma unroll
        for (int ai = 0; ai < 2; ++ai)
#pragma unroll
            for (int m = 0; m < 4; ++m) { const int r = ai * HALF + wr * 64 + m * 16 + fr; const f32x2v sr = S[r]; const size_t off = (size_t)(u.pm * BM + r) * ldc + col0;
#pragma unroll
                for (int bj = 0; bj < 2; ++bj)
#pragma unroll
                    for (int n = 0; n < 2; ++n) { const f32x4 bs = *(const f32x4*)(base + off + bj * HALF + n * 16); acc[ai][bj][m][n] = bs + (acc[ai][bj][m][n] - sr.x) * sr.y; }
                asm volatile("" : "+v"(acc[ai][0][m][0]), "+v"(acc[ai][0][m][1]), "+v"(acc[ai][1][m][0]), "+v"(acc[ai][1][m][1]));
                if (m & 1) asm volatile("" ::: "memory"); }
        const bool bad1 = bad;
        bad = st2.run(acc, u, wr, wc, fr, fq, lds, wid, lane) || bad;
#pragma unroll
        for (int ai = 0; ai < 2; ++ai)
#pragma unroll
            for (int m = 0; m < 4; ++m) { const int r = ai * HALF + wr * 64 + m * 16 + fr; const f32x2v sr = S[r]; const size_t off = (size_t)(u.pm * BM + r) * ldc + col0;
#pragma unroll
                for (int bj = 0; bj < 2; ++bj)
#pragma unroll
                    for (int n = 0; n < 2; ++n) { const f32x4 x1 = acc[ai][bj][m][n]; *(f32x4*)(out + off + bj * HALF + n * 16) = bad1 ? (f32x4){qnan, qnan, qnan, qnan} : x1;
                        const f32x4 o = (x1 - sr.x) * sr.y; u32x2v w; w.x = cvt_pk_bf16(o[0], o[1]); w.y = cvt_pk_bf16(o[2], o[3]);
                        if (bad) { w.x = 0x7fc07fc0u; w.y = 0x7fc07fc0u; } *(u32x2v*)(xn + off + bj * HALF + n * 16) = w; }
                asm volatile("" ::: "memory"); }
    }
};

template <class Epi, class Sched, bool ALIGN_EPI = false, bool SP2 = false>
__device__ __forceinline__ void gemm_phase(PG8_LAS unsigned char* lds, const Gemm g, const Sched& S, const Epi& E) {
    const int tid = threadIdx.x, wid = __builtin_amdgcn_readfirstlane(tid >> 6), lane = tid & 63, wr = wid >> 2, wc = wid & 3, fr = lane & 15, fq = lane >> 4;
    const int K = g.K, nt = K / BK;
    unsigned voffA[2], voffB[2];
#pragma unroll
    for (int i = 0; i < 2; ++i) { int R, C; stage_rc(tid * 16 + i * 8192, R, C); const int Rb = Epi::PERM ? ((R & ~31) + perm32(R & 31)) : R;
        voffA[i] = (unsigned)(R * g.lda + C) * 2u; voffB[i] = (unsigned)(Rb * g.ldb + C) * 2u; }
    const size_t kstep = (size_t)(BK * 2);
    const size_t hstepA = (size_t)HALF * g.lda * 2, hstepB = (size_t)HALF * g.ldb * 2;
    const size_t tstepA = 2 * hstepA, tstepB = 2 * hstepB;
    const size_t pnA = (size_t)g.a_pn_cols * 2;
    const unsigned ldsw = (unsigned)wid * 1024u;
    const int aoff = lds_byte(wr * 64 + fr, fq * 8), boff = lds_byte(wc * 32 + fr, fq * 8);
#define PG8_SA(b, h) (((b) * 2 + (h)) * HTB)
#define PG8_SB(b, h) ((4 + (b) * 2 + (h)) * HTB)
#define PG8_STAGE(bufoff, gbase, voff) do { _Pragma("unroll") for (int _i = 0; _i < 2; ++_i) \
        __builtin_amdgcn_global_load_lds((const unsigned*)((const char*)(gbase) + (voff)[_i]), (PG8_LAS unsigned*)(lds + (bufoff) + ldsw + _i * 8192), 16, 0, 0); } while (0)
#define PG8_LDA(dst, b, h) do { _Pragma("unroll") for (int m = 0; m < 4; ++m) _Pragma("unroll") for (int k = 0; k < 2; ++k) dst[m][k] = *(const PG8_LAS bf16x8*)(lds + PG8_SA(b, h) + aoff + m * 2048 + k * 1024); } while (0)
#define PG8_LDB(dst, b, h) do { _Pragma("unroll") for (int n = 0; n < 2; ++n) _Pragma("unroll") for (int k = 0; k < 2; ++k) dst[n][k] = *(const PG8_LAS bf16x8*)(lds + PG8_SB(b, h) + boff + n * 2048 + k * 1024); } while (0)
#define PG8_MMA(ai, bj, At, Bt) do { __builtin_amdgcn_s_setprio(1); _Pragma("unroll") for (int m = 0; m < 4; ++m) _Pragma("unroll") for (int n = 0; n < 2; ++n) _Pragma("unroll") for (int k = 0; k < 2; ++k) \
        acc[ai][bj][m][n] = __builtin_amdgcn_mfma_f32_16x16x32_bf16(Bt[n][k], At[m][k], acc[ai][bj][m][n], 0, 0, 0); __builtin_amdgcn_s_setprio(0); } while (0)
#define PG8_WAIT_V(n) asm volatile("s_waitcnt vmcnt(" #n ")" ::: "memory")
#define PG8_WAIT_L(n) asm volatile("s_waitcnt lgkmcnt(" #n ")" ::: "memory")
#define PG8_BAR __builtin_amdgcn_s_barrier()
#define PG8_SCHED __builtin_amdgcn_sched_barrier(0)
    Unit cur, nxt; int ui = 0;
    if (!S.next(0, cur)) return;
    f32x4 acc[2][2][4][2];
#pragma unroll
    for (int a = 0; a < 2; ++a)
#pragma unroll
        for (int b = 0; b < 2; ++b)
#pragma unroll
            for (int m = 0; m < 4; ++m)
#pragma unroll
                for (int n = 0; n < 2; ++n) acc[a][b][m][n] = (f32x4){0.f, 0.f, 0.f, 0.f};
    bf16x8 At[4][2], B0[2][2], B1[2][2];
    const char* cA = (const char*)g.A + (size_t)cur.pm * tstepA + (size_t)cur.pn * pnA; const char* cB = (const char*)g.Bt + (size_t)cur.pn * tstepB;
    S.a_ready(cur);
    if constexpr (SP2) {
        PG8_STAGE(PG8_SB(0, 0), cB, voffB); PG8_STAGE(PG8_SB(0, 1), cB + hstepB, voffB); PG8_STAGE(PG8_SA(0, 0), cA, voffA); PG8_STAGE(PG8_SA(0, 1), cA + hstepA, voffA);
        if (wr == 1) PG8_BAR;
        PG8_WAIT_V(2); PG8_BAR;
        PG8_STAGE(PG8_SB(1, 0), cB + kstep, voffB); PG8_STAGE(PG8_SA(1, 0), cA + kstep, voffA); PG8_STAGE(PG8_SB(1, 1), cB + hstepB + kstep, voffB);
        PG8_WAIT_V(6); PG8_BAR;
    } else {
        PG8_STAGE(PG8_SB(0, 0), cB, voffB); PG8_STAGE(PG8_SA(0, 0), cA, voffA); PG8_STAGE(PG8_SB(0, 1), cB + hstepB, voffB); PG8_STAGE(PG8_SA(0, 1), cA + hstepA, voffA);
        if (wr == 1) PG8_BAR;
        PG8_WAIT_V(4); PG8_BAR;
        PG8_STAGE(PG8_SB(1, 0), cB + kstep, voffB); PG8_STAGE(PG8_SA(1, 0), cA + kstep, voffA); PG8_STAGE(PG8_SB(1, 1), cB + hstepB + kstep, voffB);
        PG8_WAIT_V(6); PG8_BAR;
    }
    for (;;) {
        const bool has_next = S.next(ui + 1, nxt);
        const char* nA = has_next ? (const char*)g.A + (size_t)nxt.pm * tstepA + (size_t)nxt.pn * pnA : cA; const char* nB = has_next ? (const char*)g.Bt + (size_t)nxt.pn * tstepB : cB;
#pragma unroll 1
        for (int t = 0; t < nt; t += 2) {
            const bool last = (t == nt - 2);
            const char* a1 = cA + (size_t)(t + 1) * kstep;
            const char* a2 = last ? nA : cA + (size_t)(t + 2) * kstep; const char* b2 = last ? nB : cB + (size_t)(t + 2) * kstep;
            const char* a3 = a2 + kstep; const char* b3 = b2 + kstep;
            if (last && has_next) S.a_ready(nxt);
            if constexpr (Epi::HAS_MID) { if (t == nt / 2) E.mid(acc, cur, wr, wc, fr, fq); }
            if constexpr (SP2) {
            PG8_LDB(B0, 0, 0); PG8_LDB(B1, 0, 1); PG8_SCHED; PG8_LDA(At, 0, 0); PG8_STAGE(PG8_SA(1, 1), a1 + hstepA, voffA);
            PG8_WAIT_V(8); PG8_WAIT_L(0); PG8_BAR; PG8_MMA(0, 0, At, B0); PG8_MMA(0, 1, At, B1); PG8_BAR; PG8_SCHED;
            PG8_LDA(At, 0, 1); PG8_STAGE(PG8_SB(0, 0), b2, voffB); PG8_STAGE(PG8_SB(0, 1), b2 + hstepB, voffB); PG8_STAGE(PG8_SA(0, 0), a2, voffA);
            PG8_WAIT_V(8); PG8_WAIT_L(0); PG8_BAR; PG8_MMA(1, 0, At, B0); PG8_MMA(1, 1, At, B1); PG8_BAR; PG8_SCHED;
            PG8_LDB(B0, 1, 0); PG8_LDB(B1, 1, 1); PG8_SCHED; PG8_LDA(At, 1, 0); PG8_STAGE(PG8_SA(0, 1), a2 + hstepA, voffA);
            PG8_WAIT_V(8); PG8_WAIT_L(0); PG8_BAR; PG8_MMA(0, 0, At, B0); PG8_MMA(0, 1, At, B1); PG8_BAR; PG8_SCHED;
            PG8_LDA(At, 1, 1); PG8_STAGE(PG8_SB(1, 0), b3, voffB); PG8_STAGE(PG8_SB(1, 1), b3 + hstepB, voffB); PG8_STAGE(PG8_SA(1, 0), a3, voffA);
            PG8_WAIT_V(8); PG8_WAIT_L(0); PG8_BAR; PG8_MMA(1, 0, At, B0); PG8_MMA(1, 1, At, B1); PG8_BAR; PG8_SCHED;
            } else {
            PG8_LDB(B0, 0, 0); PG8_SCHED; PG8_LDA(At, 0, 0); PG8_STAGE(PG8_SA(1, 1), a1 + hstepA, voffA);
            PG8_WAIT_L(8); PG8_BAR; PG8_WAIT_L(0); PG8_MMA(0, 0, At, B0); PG8_BAR; PG8_SCHED;
            PG8_LDB(B1, 0, 1); PG8_STAGE(PG8_SB(0, 0), b2, voffB);
            PG8_BAR; PG8_WAIT_L(0); PG8_MMA(0, 1, At, B1); PG8_BAR;
            PG8_LDA(At, 0, 1); PG8_STAGE(PG8_SA(0, 0), a2, voffA);
            PG8_BAR; PG8_WAIT_L(0); PG8_MMA(1, 0, At, B0); PG8_BAR; PG8_SCHED;
            PG8_STAGE(PG8_SB(0, 1), b2 + hstepB, voffB);
            PG8_WAIT_V(6); PG8_BAR; PG8_MMA(1, 1, At, B1); PG8_BAR;
            PG8_LDB(B0, 1, 0); PG8_SCHED; PG8_LDA(At, 1, 0); PG8_STAGE(PG8_SA(0, 1), a2 + hstepA, voffA);
            PG8_WAIT_L(8); PG8_BAR; PG8_WAIT_L(0); PG8_MMA(0, 0, At, B0); PG8_BAR; PG8_SCHED;
            PG8_LDB(B1, 1, 1); PG8_STAGE(PG8_SB(1, 0), b3, voffB);
            PG8_BAR; PG8_WAIT_L(0); PG8_MMA(0, 1, At, B1); PG8_BAR;
            PG8_LDA(At, 1, 1); PG8_STAGE(PG8_SA(1, 0), a3, voffA);
            PG8_BAR; PG8_WAIT_L(0); PG8_MMA(1, 0, At, B0); PG8_BAR; PG8_SCHED;
            PG8_STAGE(PG8_SB(1, 1), b3 + hstepB, voffB);
            PG8_WAIT_V(6); PG8_BAR; PG8_MMA(1, 1, At, B1); PG8_BAR;
            }
        }
        if constexpr (ALIGN_EPI) { if (wr == 0) PG8_BAR; }
        if constexpr (!Epi::AFTER_DRAIN) { E(acc, cur, wr, wc, fr, fq); S.done(cur); }
        if (!has_next) break;
#pragma unroll
        for (int a = 0; a < 2; ++a)
#pragma unroll
            for (int b = 0; b < 2; ++b)
#pragma unroll
                for (int m = 0; m < 4; ++m)
#pragma unroll
                    for (int n = 0; n < 2; ++n) acc[a][b][m][n] = (f32x4){0.f, 0.f, 0.f, 0.f};
        cur = nxt; cA = nA; cB = nB; ++ui;
        if constexpr (ALIGN_EPI) { if (wr == 1) PG8_BAR; }
    }
    PG8_WAIT_V(0);
    if constexpr (!ALIGN_EPI) { if (wr == 0) PG8_BAR; }
    PG8_BAR;
    if constexpr (Epi::AFTER_DRAIN) { E.fused(acc, cur, wr, wc, fr, fq, lds, wid, lane); S.done(cur); }
#undef PG8_SA
#undef PG8_SB
#undef PG8_STAGE
#undef PG8_LDA
#undef PG8_LDB
#undef PG8_MMA
#undef PG8_WAIT_V
#undef PG8_WAIT_L
#undef PG8_BAR
#undef PG8_SCHED
}
}

constexpr int NWAVES = 8;
constexpr int M = 16384, D = 1024, SEQ = 2048;
constexpr int N1 = 7168;
constexpr int W_IN_LD = 7184;
constexpr float LN_EPS = 1e-5f, RMS_EPS = 1e-5f;
constexpr float ALPHA = 1.189207115002721f;
constexpr float QSCALE = 0.08838834764831845f;

constexpr size_t MiB = 1u << 20;
constexpr size_t WS_CTL = 0, CTL_ZERO_BYTES = 1 * MiB;
constexpr size_t WS_ALOW = 1 * MiB;
constexpr size_t WS_WAB = 2 * MiB;
constexpr size_t WS_WO = 6 * MiB;
constexpr size_t WS_WP = 8 * MiB;
constexpr size_t WS_WIN = 10 * MiB;
constexpr size_t WS_PS = 10 * MiB;
constexpr size_t WS_GD = 18 * MiB;
constexpr size_t WS_T0 = 24 * MiB, TS = 32 * MiB;
constexpr size_t WS_QK = WS_T0, WS_U = WS_T0 + TS, WS_V = WS_T0 + 2 * TS, WS_G = WS_T0 + 3 * TS, WS_Z = WS_T0 + 4 * TS, WS_GA = WS_T0 + 5 * TS, WS_GB = WS_T0 + 6 * TS;
constexpr size_t WS_YAB = WS_T0;
constexpr size_t WS_MG = WS_V;
constexpr size_t WS_END = WS_T0 + 7 * TS;
constexpr size_t DO_XB = 0, DO_PP = 0, DO_QE = 32 * MiB, DO_KD = 48 * MiB;

constexpr int CW_TMO = 0, CW_CODE = 1, CW_BAR = 4096;
constexpr int LDS_BYTES = 147456;
constexpr int MISC_OFF = LDS_BYTES - 128;

#define GAS __attribute__((address_space(1)))
#define LAS __attribute__((address_space(3)))
typedef unsigned short bf16;
typedef unsigned v4u __attribute__((ext_vector_type(4)));
typedef unsigned v2u __attribute__((ext_vector_type(2)));
typedef float f32x4 __attribute__((ext_vector_type(4)));
typedef short bf16x8 __attribute__((ext_vector_type(8)));
typedef short s16x4 __attribute__((ext_vector_type(4)));
typedef short v4i16_t __attribute__((ext_vector_type(4)));
typedef GAS unsigned gu32;
#define RLX_AGENT __ATOMIC_RELAXED, __HIP_MEMORY_SCOPE_AGENT
#define LDS_WAIT() asm volatile("s_waitcnt lgkmcnt(0)" ::: "memory")
#define VM_WAIT() asm volatile("s_waitcnt vmcnt(0)" ::: "memory")
__device__ __forceinline__ unsigned f2bf(float f) { unsigned u = __builtin_bit_cast(unsigned, f); return (u + 0x7fffu + ((u >> 16) & 1u)) >> 16; }
__device__ __forceinline__ unsigned pk2(float lo, float hi) { return f2bf(lo) | (f2bf(hi) << 16); }
__device__ __forceinline__ float bf2f(unsigned b) { return __builtin_bit_cast(float, b << 16); }
__device__ __forceinline__ float bflo(unsigned w) { return __builtin_bit_cast(float, w << 16); }
__device__ __forceinline__ float bfhi(unsigned w) { return __builtin_bit_cast(float, w & 0xffff0000u); }
__device__ __forceinline__ float sigm(float x) { return __builtin_amdgcn_rcpf(1.0f + __expf(-x)); }
__device__ __forceinline__ float clampf(float x, float lo, float hi) { return fminf(fmaxf(x, lo), hi); }

#define XB_TMO      128
#define XB_XCNT(j)  (256  + 64 * (j))
#define XB_XSUB(j)  (1280 + 64 * (j))
#define XB_XGEN(j)  (2304 + 64 * (j))
#define XB_TOP      3328
#define XB_TOPGEN   3392
#define XCD_BAR_WORDS 3456
#define XB_SPIN_CAP (1u << 18)

__device__ __forceinline__ unsigned xb_ld(unsigned* p)              { return __hip_atomic_load(p, __ATOMIC_RELAXED, __HIP_MEMORY_SCOPE_AGENT); }
__device__ __forceinline__ unsigned xb_add(unsigned* p, unsigned v) { return __hip_atomic_fetch_add(p, v, __ATOMIC_RELAXED, __HIP_MEMORY_SCOPE_AGENT); }
__device__ __forceinline__ unsigned xb_xcc_id() { return (unsigned)__builtin_amdgcn_s_getreg((3 << 11) | 20) & 0xFu; }
#define XB_SPIN(cond, bar) do { unsigned _sp = 0; while (cond) { __builtin_amdgcn_s_sleep(1); \
    if ((++_sp & 255u) == 0u) { if (xb_ld(&(bar)[XB_TMO])) break; if (_sp > XB_SPIN_CAP) { atomicAdd(&(bar)[XB_TMO], 1u); break; } } } } while (0)

struct XcdBarrier {
    unsigned* bar; unsigned x;
    volatile LAS unsigned* st;
};

__device__ __forceinline__ XcdBarrier xcd_barrier_post(unsigned* bar, volatile LAS unsigned* st) {
    XcdBarrier b; b.bar = bar; b.x = xb_xcc_id(); b.st = st;
    if (threadIdx.x == 0) (void)xb_add(&bar[XB_XCNT(b.x)], 1u);
    return b;
}
__device__ __forceinline__ void xcd_barrier_complete(unsigned* bar, unsigned x, unsigned& nloc, unsigned& nx) {
    const unsigned G = gridDim.x * gridDim.y * gridDim.z;
    unsigned sum, cnt, mine, sp = 0u;
    for (;;) {
        sum = 0u; cnt = 0u; mine = 0u;
#pragma unroll
        for (unsigned j = 0; j < 16; ++j) { const unsigned c = xb_ld(&bar[XB_XCNT(j)]); sum += c; cnt += (c > 0u) ? 1u : 0u; mine = (j == x) ? c : mine; }
        if (sum == G) break;
        __builtin_amdgcn_s_sleep(1);
        if ((++sp & 255u) == 0u) { if (xb_ld(&bar[XB_TMO])) break; if (sp > XB_SPIN_CAP) { atomicAdd(&bar[XB_TMO], 1u); break; } }
    }
    nloc = mine > 0u ? mine : 1u; nx = cnt > 0u ? cnt : 1u;
}

__device__ __forceinline__ void xcd_barrier(const XcdBarrier& b) {
    asm volatile("s_waitcnt vmcnt(0)" ::: "memory");
    __syncthreads();
    if (threadIdx.x == 0) {
        unsigned* bar = b.bar;
        __builtin_amdgcn_s_waitcnt(0);
        unsigned nloc = b.st[0], nx = b.st[1];
        if (nloc == 0u) { xcd_barrier_complete(bar, b.x, nloc, nx); b.st[0] = nloc; b.st[1] = nx; }
        const unsigned old = xb_add(&bar[XB_XSUB(b.x)], 1u);
        const unsigned gen = old / nloc;
        if (old + 1u == (gen + 1u) * nloc) {
            __builtin_amdgcn_fence(__ATOMIC_RELEASE, "agent");
            asm volatile("s_waitcnt vmcnt(0)" ::: "memory");
            const unsigned og = xb_add(&bar[XB_TOP], 1u);
            const unsigned tg = og / nx;
            if (og + 1u == (tg + 1u) * nx) xb_add(&bar[XB_TOPGEN], 1u);
            else XB_SPIN(xb_ld(&bar[XB_TOPGEN]) == tg, bar);
            __builtin_amdgcn_fence(__ATOMIC_ACQUIRE, "agent");
            xb_add(&bar[XB_XGEN(b.x)], 1u);
            asm volatile("s_waitcnt vmcnt(0)" ::: "memory");
        } else {
            XB_SPIN(xb_ld(&bar[XB_XGEN(b.x)]) == gen, bar);
            __builtin_amdgcn_fence(__ATOMIC_ACQUIRE, "agent");
            asm volatile("s_waitcnt vmcnt(0)" ::: "memory");
        }
    }
    __syncthreads();
}


struct Args { const float* in[13]; float* out; unsigned char* ws; };
struct Frame { LAS unsigned char* lds; int tid, lane, wave, vcu, G; };

__device__ __forceinline__ float wave_sum(float v) {
#pragma unroll
    for (int o = 1; o < 64; o <<= 1) v += __shfl_xor(v, o);
    return v;
}

__device__ __forceinline__ void p0_transpose_item(const float* W, int ldw, int scol0, bf16* WT, int ldt, int drow0, int dkoff, LAS float* scr, int kb, int nb, int lane) {
    const int k0 = 64 * kb, n0 = 32 * nb;
#pragma unroll 8
    for (int i = 0; i < 32; ++i) { const int kk = 2 * i + (lane >> 5); scr[kk * 33 + (lane & 31)] = W[(size_t)(k0 + kk) * ldw + scol0 + n0 + (lane & 31)]; }
    LDS_WAIT(); asm volatile("" ::: "memory");
    const int c = lane & 7;
#pragma unroll
    for (int j = 0; j < 4; ++j) { const int n = (lane >> 3) + 8 * j; const LAS float* s = scr + (8 * c) * 33 + n;
        v4u o; o.x = pk2(s[0 * 33], s[1 * 33]); o.y = pk2(s[2 * 33], s[3 * 33]); o.z = pk2(s[4 * 33], s[5 * 33]); o.w = pk2(s[6 * 33], s[7 * 33]);
        *(GAS v4u*)(WT + (size_t)(drow0 + n0 + n) * ldt + dkoff + k0 + 8 * c) = o; }
    LDS_WAIT(); asm volatile("" ::: "memory");
}

__device__ __forceinline__ void p0_prologue(const Frame& F, const Args& a) {
    unsigned char* ws = a.ws;
    const float* x = a.in[0]; const float* w_in = a.in[1]; const float* pool_w = a.in[5]; const float* w_a = a.in[8]; const float* w_b = a.in[9]; const float* w_o = a.in[10];
    bf16* WIN = (bf16*)(ws + WS_WIN); bf16* WAB = (bf16*)(ws + WS_WAB); bf16* WO = (bf16*)(ws + WS_WO); bf16* WP = (bf16*)(ws + WS_WP);
    LAS float* scr = (LAS float*)(F.lds + F.wave * 16384);
    const int gw = F.vcu * NWAVES + F.wave, NGW = F.G * NWAVES;
    constexpr int NBIG = 10 * 512, NITEMS = NBIG + 4 * 32;
    for (int it = gw; it < NITEMS; it += NGW) {
        if (it < NBIG) {
            const int seg = it >> 9, r = it & 511, kb = r >> 5, nb = r & 31;
            if (seg < 7) {
                const int scol0 = seg == 0 ? 0 : seg == 1 ? 3088 : seg == 2 ? 1024 : seg == 3 ? 2048 : seg == 4 ? 4112 : seg == 5 ? 5136 : 6160;
                p0_transpose_item(w_in, W_IN_LD, scol0, WIN, 1024, 1024 * seg, 0, scr, kb, nb, F.lane);
            } else if (seg == 7) p0_transpose_item(w_a, 1024, 0, WAB, 2048, 0, 0, scr, kb, nb, F.lane);
            else if (seg == 8) p0_transpose_item(w_b, 1024, 0, WAB, 2048, 0, 1024, scr, kb, nb, F.lane);
            else p0_transpose_item(w_o, 1024, 0, WO, 1024, 0, 0, scr, kb, nb, F.lane);
        } else {
            const int r0 = it - NBIG, g = r0 >> 5, r = r0 & 31, kb = r >> 3, nb = r & 7;
            p0_transpose_item(pool_w + (size_t)g * 65536, 256, 0, WP + (size_t)g * 65536, 256, 0, 0, scr, kb, nb, F.lane);
        }
    }
    __syncthreads();
    LAS float* wal = (LAS float*)F.lds;
#pragma unroll
    for (int i = 0; i < 2; ++i) { const int k = F.tid + 512 * i; const GAS f32x4* src = (const GAS f32x4*)(w_in + (size_t)k * W_IN_LD + 3072);
#pragma unroll
        for (int q = 0; q < 4; ++q) { const f32x4 v = src[q]; wal[(4 * q + 0) * 1024 + k] = v.x; wal[(4 * q + 1) * 1024 + k] = v.y; wal[(4 * q + 2) * 1024 + k] = v.z; wal[(4 * q + 3) * 1024 + k] = v.w; } }
    __syncthreads();
    bf16* XB = (bf16*)((unsigned char*)a.out + DO_XB); float* ALOW = (float*)(ws + WS_ALOW);
    for (int m = gw; m < M; m += NGW) {
        const GAS f32x4* xr = (const GAS f32x4*)(x + (size_t)m * D) + F.lane;
        f32x4 v[4];
#pragma unroll
        for (int j = 0; j < 4; ++j) v[j] = xr[64 * j];
        GAS unsigned long long* o8 = (GAS unsigned long long*)(XB + (size_t)m * D) + F.lane;
#pragma unroll
        for (int j = 0; j < 4; ++j) o8[64 * j] = (unsigned long long)pk2(v[j].x, v[j].y) | ((unsigned long long)pk2(v[j].z, v[j].w) << 32);
        float acc[16];
#pragma unroll
        for (int r = 0; r < 16; ++r) acc[r] = 0.f;
#pragma unroll
        for (int j = 0; j < 4; ++j)
#pragma unroll
            for (int r = 0; r < 16; ++r) { const f32x4 w = *(const LAS f32x4*)(wal + r * 1024 + 256 * j + 4 * F.lane); acc[r] += (v[j].x * w.x + v[j].y * w.y) + (v[j].z * w.z + v[j].w * w.w);
                if ((r & 3) == 3) asm volatile("" ::: "memory"); }
        float mine = 0.f;
#pragma unroll
        for (int r = 0; r < 16; ++r) { const float s = wave_sum(acc[r]); mine = (F.lane == r) ? s : mine; }
        if (F.lane < 16) ALOW[(size_t)m * 16 + F.lane] = mine;
    }
}

__device__ __forceinline__ void unpack8(const v4u w, float (&f)[8]) { f[0] = bflo(w.x); f[1] = bfhi(w.x); f[2] = bflo(w.y); f[3] = bfhi(w.y); f[4] = bflo(w.z); f[5] = bfhi(w.z); f[6] = bflo(w.w); f[7] = bfhi(w.w); }

__device__ __forceinline__ void pool_elementwise(const Frame& F, const bf16* U, bf16* PP) {
    const int task = F.vcu * 512 + F.tid;
    if (task >= 128 * (M / 16)) return;
    const int c8 = task & 127, strip = task >> 7, grp = c8 >> 5, w = 2 << grp;
    const int r0 = strip * 16, pos0 = r0 & (SEQ - 1);
    const GAS v4u* up = (const GAS v4u*)(U + (size_t)c8 * 8);
    float sum[8];
#pragma unroll
    for (int e = 0; e < 8; ++e) sum[e] = 0.f;
    for (int j = 1; j < w; ++j) if (pos0 - j >= 0) { float f[8]; unpack8(up[(size_t)(r0 - j) * 128], f);
#pragma unroll
        for (int e = 0; e < 8; ++e) sum[e] += f[e]; }
    for (int i = 0; i < 16; ++i) {
        const int row = r0 + i, pos = pos0 + i;
        float f[8]; unpack8(up[(size_t)row * 128], f);
        const int cnt = (pos + 1 < w) ? pos + 1 : w; const float inv = 1.0f / (float)cnt;
        float p[8];
#pragma unroll
        for (int e = 0; e < 8; ++e) { sum[e] += f[e]; p[e] = sum[e] * inv - f[e]; }
        v4u o; o.x = pk2(p[0], p[1]); o.y = pk2(p[2], p[3]); o.z = pk2(p[4], p[5]); o.w = pk2(p[6], p[7]);
        *(GAS v4u*)(PP + (size_t)row * 1024 + c8 * 8) = o;
        if (pos - w + 1 >= 0) { float g[8]; unpack8(up[(size_t)(row - w + 1) * 128], g);
#pragma unroll
            for (int e = 0; e < 8; ++e) sum[e] -= g[e]; }
    }
}

__device__ __forceinline__ float logsigmoid_f(float x) { return fminf(x, 0.f) - __logf(1.0f + __expf(-fabsf(x))); }

__device__ __forceinline__ void prep_unit(const Frame& F, const Args& a, int u) {
    unsigned char* ws = a.ws;
    const int c = u & 31, h = (u >> 5) & 3, b = u >> 7; const int t0 = b * SEQ + 64 * c;
    const float* ALOW = (const float*)(ws + WS_ALOW); const float* Wg = a.in[2]; const float* bg = a.in[3];
    const bf16* QK = (const bf16*)(ws + WS_QK);
    bf16* QE = (bf16*)((unsigned char*)a.out + DO_QE); bf16* KD = (bf16*)((unsigned char*)a.out + DO_KD);
    bf16* PS = (bf16*)(ws + WS_PS) + (size_t)u * 3072; float* GD = (float*)(ws + WS_GD) + (size_t)u * 128;
    LAS float* al = (LAS float*)(F.lds);
    LAS float* tot = (LAS float*)(F.lds + 4096);
    LAS bf16* qeL = (LAS bf16*)(F.lds + 8192);
    LAS bf16* knL = (LAS bf16*)(F.lds + 8192 + 17408);
    __syncthreads();
    if (F.tid < 256) { const f32x4 v = *(const GAS f32x4*)(ALOW + (size_t)(t0 + (F.tid >> 2)) * 16 + (F.tid & 3) * 4); *(LAS f32x4*)(al + (F.tid >> 2) * 16 + (F.tid & 3) * 4) = v; }
    const int k = F.tid & 127, tg = F.tid >> 7;
    float wg[16];
#pragma unroll
    for (int r = 0; r < 16; ++r) wg[r] = Wg[r * 512 + 128 * h + k];
    const float bgk = bg[128 * h + k];
    __syncthreads();
    float bc[16]; float run = 0.f;
#pragma unroll
    for (int i = 0; i < 16; ++i) {
        const LAS f32x4* ap = (const LAS f32x4*)(al + (16 * tg + i) * 16);
        const f32x4 a0 = ap[0], a1 = ap[1], a2 = ap[2], a3 = ap[3];
        float s = bgk;
        s += a0.x * wg[0]; s += a0.y * wg[1]; s += a0.z * wg[2]; s += a0.w * wg[3];
        s += a1.x * wg[4]; s += a1.y * wg[5]; s += a1.z * wg[6]; s += a1.w * wg[7];
        s += a2.x * wg[8]; s += a2.y * wg[9]; s += a2.z * wg[10]; s += a2.w * wg[11];
        s += a3.x * wg[12]; s += a3.y * wg[13]; s += a3.z * wg[14]; s += a3.w * wg[15];
        run += logsigmoid_f(s) * (1.0f / 16.0f); bc[i] = run;
    }
    tot[tg * 128 + k] = run;
    __syncthreads();
    float pre = 0.f, blast = 0.f;
#pragma unroll
    for (int g2 = 0; g2 < 4; ++g2) { const float t = tot[g2 * 128 + k]; blast += t; pre += (g2 < tg) ? t : 0.f; }
#pragma unroll
    for (int i = 0; i < 16; ++i) {
        const int tok = 16 * tg + i; const size_t row = (size_t)(t0 + tok); const float bb = pre + bc[i];
        const float qv = bf2f(QK[row * 1024 + 128 * h + k]), kv = bf2f(QK[row * 1024 + 512 + 128 * h + k]);
        const float qe = qv * QSCALE * __expf(bb), kn = kv * __expf(-bb), kd = kv * __expf(blast - bb);
        const bf16 qeb = (bf16)f2bf(qe);
        QE[row * 512 + 128 * h + k] = qeb; KD[row * 512 + 128 * h + k] = (bf16)f2bf(kd);
        qeL[tok * 136 + k] = qeb; knL[tok * 136 + k] = (bf16)f2bf(kn);
    }
    if (tg == 0) GD[k] = __expf(blast);
    __syncthreads();
    const int g = F.lane >> 4, i = F.lane & 15, ti = F.wave >> 1;
#pragma unroll
    for (int tjj = 0; tjj < 2; ++tjj) {
        const int tj = 2 * (F.wave & 1) + tjj;
        f32x4 acc = (f32x4){0.f, 0.f, 0.f, 0.f};
        if (tj <= ti) {
#pragma unroll
            for (int s = 0; s < 4; ++s) {
                const bf16x8 af = *(const LAS bf16x8*)(qeL + (16 * ti + i) * 136 + 32 * s + 8 * g);
                const bf16x8 bfr = *(const LAS bf16x8*)(knL + (16 * tj + i) * 136 + 32 * s + 8 * g);
                acc = __builtin_amdgcn_mfma_f32_16x16x32_bf16(af, bfr, acc, 0, 0, 0);
            }
        }
#pragma unroll
        for (int r = 0; r < 4; ++r) {
            const int row = 16 * ti + 4 * g + r, col = 16 * tj + i;
            const float v = (col <= row) ? acc[r] : 0.f;
            if (row < 32) { if (col < 32) PS[row * 32 + col] = (bf16)f2bf(v); }
            else PS[1024 + (row - 32) * 64 + col] = (bf16)f2bf(v);
        }
    }
}

constexpr int L_QE = 0, L_KD = 32768, L_V = 65536, L_PS = 131072, L_GD = 143360, SC_SSQ = 144384;
static_assert(SC_SSQ + 2048 <= MISC_OFF, "scan LDS map");
__device__ __forceinline__ int swz(int row, int cb, int rb) { return row * rb + (cb ^ ((row & 15) << 4)); }
__device__ __forceinline__ s16x4 tr_read(const LAS unsigned char* p) { return __builtin_bit_cast(s16x4, __builtin_amdgcn_ds_read_tr16_b64_v4i16((LAS v4i16_t*)p)); }

struct ScanPtrs { const bf16* QE; const bf16* KD; const bf16* V; const bf16* PS; const float* GD; };

struct ScanLane {
    const LAS unsigned char* qe[4][2]; const LAS unsigned char* kd[8][2]; const LAS unsigned char* v[2][2]; const LAS unsigned char* psa; const LAS unsigned char* psb; const LAS unsigned char* gd;
    unsigned dqk, dv, dps, dgd;
    unsigned goff, yoff;
};

template <int STG>
__device__ __forceinline__ void scan_stage_issue(const Frame& F, const ScanPtrs& P, const ScanLane& A, int t0, int u) {
    const int w = F.wave;
    unsigned dqk = A.dqk, dv = A.dv; asm volatile("" : "+v"(dqk), "+v"(dv));
    const char* qb = (const char*)P.QE + (size_t)t0 * 1024; const char* kb = (const char*)P.KD + (size_t)t0 * 1024; const char* vb = (const char*)P.V + (size_t)t0 * 2048;
#pragma unroll
    for (int j = 0; j < 2; ++j) {
        __builtin_amdgcn_global_load_lds((const unsigned*)(qb + (dqk + j * 32768u)), (LAS unsigned*)(F.lds + L_QE + STG * 16384 + (w + 8 * j) * 1024), 16, 0, 0);
        __builtin_amdgcn_global_load_lds((const unsigned*)(kb + (dqk + j * 32768u)), (LAS unsigned*)(F.lds + L_KD + STG * 16384 + (w + 8 * j) * 1024), 16, 0, 0);
    }
#pragma unroll
    for (int j = 0; j < 4; ++j)
        __builtin_amdgcn_global_load_lds((const unsigned*)(vb + (dv + j * 32768u)), (LAS unsigned*)(F.lds + L_V + STG * 32768 + (w + 8 * j) * 1024), 16, 0, 0);
    if (w < 6) __builtin_amdgcn_global_load_lds((const unsigned*)((const char*)P.PS + (size_t)u * 6144 + A.dps), (LAS unsigned*)(F.lds + L_PS + STG * 6144 + w * 1024), 16, 0, 0);
    else __builtin_amdgcn_global_load_lds((const unsigned*)((const char*)P.GD + (size_t)u * 512 + A.dgd), (LAS unsigned*)(F.lds + L_GD + STG * 512 + (w - 6) * 256), 4, 0, 0);
}


template <int STG>
__device__ __forceinline__ void scan_step(const Frame& F, const ScanLane& A, f32x4 (&S)[2][8], const float (&gn)[2], const bf16* G, bf16* YAB, int t0) {
    const int w = F.wave, lane = F.lane, g = lane >> 4, i = lane & 15;
    LAS float* SSQ = (LAS float*)(F.lds + SC_SSQ);
    unsigned gq[4][2][4];
    {
        unsigned go = A.goff; asm volatile("" : "+v"(go));
        const char* gb = (const char*)G + (size_t)t0 * 2048;
#pragma unroll
        for (int rb = 0; rb < 4; ++rb)
#pragma unroll
            for (int cg = 0; cg < 2; ++cg)
#pragma unroll
                for (int r = 0; r < 4; ++r) gq[rb][cg][r] = *(const bf16*)(gb + (go + (unsigned)((16 * rb + r) * 2048 + 32 * cg)));
    }
    f32x4 O[4][2];
#pragma unroll
    for (int rb = 0; rb < 4; ++rb) { O[rb][0] = (f32x4){0.f, 0.f, 0.f, 0.f}; O[rb][1] = (f32x4){0.f, 0.f, 0.f, 0.f}; }
#pragma unroll
    for (int s = 0; s < 4; ++s) {
        bf16x8 Sf[2];
#pragma unroll
        for (int cg = 0; cg < 2; ++cg) { v4u pk; pk.x = pk2(S[cg][2 * s][0], S[cg][2 * s][1]); pk.y = pk2(S[cg][2 * s][2], S[cg][2 * s][3]); pk.z = pk2(S[cg][2 * s + 1][0], S[cg][2 * s + 1][1]); pk.w = pk2(S[cg][2 * s + 1][2], S[cg][2 * s + 1][3]); Sf[cg] = __builtin_bit_cast(bf16x8, pk); }
#pragma unroll
        for (int rb = 0; rb < 4; ++rb) {
            const v2u lo = *(const LAS v2u*)(A.qe[s][0] + STG * 16384 + rb * 4096);
            const v2u hi = *(const LAS v2u*)(A.qe[s][1] + STG * 16384 + rb * 4096);
            v4u av; av.x = lo.x; av.y = lo.y; av.z = hi.x; av.w = hi.y;
            const bf16x8 af = __builtin_bit_cast(bf16x8, av);
            O[rb][0] = __builtin_amdgcn_mfma_f32_16x16x32_bf16(af, Sf[0], O[rb][0], 0, 0, 0);
            O[rb][1] = __builtin_amdgcn_mfma_f32_16x16x32_bf16(af, Sf[1], O[rb][1], 0, 0, 0);
        }
    }
    bf16x8 vf[2][2];
#pragma unroll
    for (int ks = 0; ks < 2; ++ks)
#pragma unroll
        for (int cg = 0; cg < 2; ++cg) {
            const s16x4 lo = tr_read(A.v[cg][0] + STG * 32768 + ks * 16384);
            const s16x4 hi = tr_read(A.v[cg][1] + STG * 32768 + ks * 16384);
            vf[ks][cg] = (bf16x8){lo[0], lo[1], lo[2], lo[3], hi[0], hi[1], hi[2], hi[3]};
        }
#pragma unroll
    for (int rb = 0; rb < 4; ++rb)
#pragma unroll
        for (int ks = 0; ks < 2; ++ks) {
            if (ks == 1 && rb < 2) continue;
            const LAS unsigned char* pp = (rb < 2) ? (A.psa + STG * 6144 + rb * 1024) : (A.psb + STG * 6144 + (rb - 2) * 2048 + 64 * ks);
            const bf16x8 af = *(const LAS bf16x8*)pp;
            O[rb][0] = __builtin_amdgcn_mfma_f32_16x16x32_bf16(af, vf[ks][0], O[rb][0], 0, 0, 0);
            O[rb][1] = __builtin_amdgcn_mfma_f32_16x16x32_bf16(af, vf[ks][1], O[rb][1], 0, 0, 0);
        }
#pragma unroll
    for (int t = 0; t < 8; ++t) {
        const f32x4 gd4 = *(const LAS f32x4*)(A.gd + STG * 512 + t * 64);
        S[0][t] = S[0][t] * gd4; S[1][t] = S[1][t] * gd4;
#pragma unroll
        for (int ks = 0; ks < 2; ++ks) {
            const s16x4 lo = tr_read(A.kd[t][0] + STG * 16384 + ks * 8192);
            const s16x4 hi = tr_read(A.kd[t][1] + STG * 16384 + ks * 8192);
            const bf16x8 af = (bf16x8){lo[0], lo[1], lo[2], lo[3], hi[0], hi[1], hi[2], hi[3]};
            S[0][t] = __builtin_amdgcn_mfma_f32_16x16x32_bf16(af, vf[ks][0], S[0][t], 0, 0, 0);
            S[1][t] = __builtin_amdgcn_mfma_f32_16x16x32_bf16(af, vf[ks][1], S[1][t], 0, 0, 0);
        }
    }
#pragma unroll
    for (int rb = 0; rb < 4; ++rb)
#pragma unroll
        for (int r = 0; r < 4; ++r) {
            float s = O[rb][0][r] * O[rb][0][r] + O[rb][1][r] * O[rb][1][r];
            s += __shfl_xor(s, 1); s += __shfl_xor(s, 2); s += __shfl_xor(s, 4); s += __shfl_xor(s, 8);
            if (i == 0) SSQ[(16 * rb + 4 * g + r) * 8 + w] = s;
        }
    __syncthreads();
    unsigned yo = A.yoff; asm volatile("" : "+v"(yo));
    char* yb = (char*)YAB + (size_t)t0 * 4096;
#pragma unroll
    for (int rb = 0; rb < 4; ++rb)
#pragma unroll
        for (int r = 0; r < 4; ++r) {
            const int row = 16 * rb + 4 * g + r;
            const f32x4 s0 = *(const LAS f32x4*)(SSQ + row * 8), s1 = *(const LAS f32x4*)(SSQ + row * 8 + 4);
            const float tot = ((s0.x + s0.y) + (s0.z + s0.w)) + ((s1.x + s1.y) + (s1.z + s1.w));
            const float rinv = __builtin_amdgcn_rsqf(tot * (1.0f / 256.0f) + RMS_EPS);
#pragma unroll
            for (int cg = 0; cg < 2; ++cg) {
                const float gv = bf2f(gq[rb][cg][r]);
                const float y = O[rb][cg][r] * rinv * gn[cg] * gv * sigm(gv);
                *(bf16*)(yb + (yo + (unsigned)((16 * rb + r) * 4096 + 32 * cg))) = (bf16)f2bf(y);
            }
        }
}

__device__ __forceinline__ void gla_scan(const Frame& F, const Args& a, int bh) {
    unsigned char* ws = a.ws;
    const int b = bh >> 2, h = bh & 3;
    ScanPtrs P; P.QE = (const bf16*)((unsigned char*)a.out + DO_QE); P.KD = (const bf16*)((unsigned char*)a.out + DO_KD);
    P.V = (const bf16*)(ws + WS_V); P.PS = (const bf16*)(ws + WS_PS); P.GD = (const float*)(ws + WS_GD);
    const bf16* G = (const bf16*)(ws + WS_G); bf16* YAB = (bf16*)(ws + WS_YAB); const float* gnw = a.in[4];
    const int w = F.wave, lane = F.lane, g = lane >> 4, i = lane & 15, q = i >> 2, p = i & 3;
    ScanLane A;
#pragma unroll
    for (int s = 0; s < 4; ++s)
#pragma unroll
        for (int hh = 0; hh < 2; ++hh) A.qe[s][hh] = F.lds + L_QE + swz(i, 64 * s + 32 * hh + 8 * g, 256);
#pragma unroll
    for (int t = 0; t < 8; ++t)
#pragma unroll
        for (int hh = 0; hh < 2; ++hh) A.kd[t][hh] = F.lds + L_KD + swz(8 * g + q + 4 * hh, 32 * t + 8 * p, 256);
#pragma unroll
    for (int cg = 0; cg < 2; ++cg)
#pragma unroll
        for (int hh = 0; hh < 2; ++hh) A.v[cg][hh] = F.lds + L_V + swz(8 * g + q + 4 * hh, 64 * w + 32 * cg + 8 * p, 512);
    A.psa = F.lds + L_PS + i * 64 + 16 * g; A.psb = F.lds + L_PS + 2048 + i * 128 + 16 * g; A.gd = F.lds + L_GD + 16 * g;
    {
        const int r4 = (4 * w + (lane >> 4)) & 15;
        A.dqk = (unsigned)(((4 * w + (lane >> 4)) * 512 + 128 * h) * 2 + (((lane & 15) ^ r4) * 16));
        const int r2 = (2 * w + (lane >> 5)) & 15;
        A.dv = (unsigned)(((2 * w + (lane >> 5)) * 1024 + 256 * h) * 2 + (((lane & 31) ^ r2) * 16));
        A.dps = (unsigned)(w * 1024 + lane * 16); A.dgd = (unsigned)(((w - 6) * 64 + lane) * 4);
        A.goff = (unsigned)((4 * g * 1024 + 256 * h + 32 * w + i) * 2);
        A.yoff = (unsigned)((4 * g * 2048 + 256 * h + 32 * w + i) * 2);
    }
    f32x4 S[2][8];
#pragma unroll
    for (int cg = 0; cg < 2; ++cg)
#pragma unroll
        for (int t = 0; t < 8; ++t) S[cg][t] = (f32x4){0.f, 0.f, 0.f, 0.f};
    float gn[2];
#pragma unroll
    for (int cg = 0; cg < 2; ++cg) gn[cg] = gnw[256 * h + 32 * w + 16 * cg + i];
    const int ubase = (b * 4 + h) * 32;
    scan_stage_issue<0>(F, P, A, b * SEQ, ubase);
#pragma unroll 1
    for (int c = 0; c < 32; c += 2) {
        const int t0 = b * SEQ + 64 * c;
        VM_WAIT(); __syncthreads();
        scan_stage_issue<1>(F, P, A, t0 + 64, ubase + c + 1);
        scan_step<0>(F, A, S, gn, G, YAB, t0);
        VM_WAIT(); __syncthreads();
        if (c + 2 < 32) scan_stage_issue<0>(F, P, A, t0 + 128, ubase + c + 2);
        scan_step<1>(F, A, S, gn, G, YAB, t0 + 64);
    }
}

namespace pg8 {
struct EpiYb {
    static constexpr bool PERM = true, AFTER_DRAIN = false, HAS_MID = false;
    const bf16_t* Z; bf16_t* YAB; const float* pb; const float* ps;
    __device__ __forceinline__ void operator()(const f32x4 (&acc)[2][2][4][2], const Unit& u, int wr, int wc, int fr, int fq) const {
        const int row0 = u.pm * BM + wr * 64 + fr, col0 = u.pn * BM + wc * 32 + 8 * fq;
#pragma unroll
        for (int bj = 0; bj < 2; ++bj) {
            const int col = col0 + bj * HALF;
            const f32x4 b0 = *(const f32x4*)(pb + col), b1 = *(const f32x4*)(pb + col + 4), s0 = *(const f32x4*)(ps + col), s1 = *(const f32x4*)(ps + col + 4);
#pragma unroll
            for (int ai = 0; ai < 2; ++ai)
#pragma unroll
                for (int m = 0; m < 4; ++m) {
                    const size_t row = (size_t)(row0 + ai * HALF + m * 16);
                    const u32x4 zw = *(const u32x4*)(Z + row * 1024 + col);
                    float z[8]; z[0] = bflo(zw.x); z[1] = bfhi(zw.x); z[2] = bflo(zw.y); z[3] = bfhi(zw.y); z[4] = bflo(zw.z); z[5] = bfhi(zw.z); z[6] = bflo(zw.w); z[7] = bfhi(zw.w);
                    f32x4 v0 = (acc[ai][bj][m][0] + b0) * s0, v1 = (acc[ai][bj][m][1] + b1) * s1;
#pragma unroll
                    for (int e = 0; e < 4; ++e) { v0[e] *= z[e] * sigm(z[e]); v1[e] *= z[4 + e] * sigm(z[4 + e]); }
                    u32x4 o; o.x = cvt_pk_bf16(v0[0], v0[1]); o.y = cvt_pk_bf16(v0[2], v0[3]); o.z = cvt_pk_bf16(v1[0], v1[1]); o.w = cvt_pk_bf16(v1[2], v1[3]);
                    *(u32x4*)(YAB + row * 2048 + 1024 + col) = o;
                    asm volatile("" ::: "memory");
                }
        }
    }
};
struct EpiMerge {
    static constexpr bool PERM = true, AFTER_DRAIN = false, HAS_MID = true;
    const bf16_t* GA; const bf16_t* GB; bf16_t* MG;
    __device__ __forceinline__ void mid(f32x4 (&acc)[2][2][4][2], const Unit& u, int wr, int wc, int fr, int fq) const {
        int zz = 0; asm volatile("" : "+v"(zz));
        const int row0 = u.pm * BM + wr * 64 + fr + zz, col0 = u.pn * BM + wc * 32 + 8 * fq;
#pragma unroll
        for (int ai = 0; ai < 2; ++ai)
#pragma unroll
            for (int m = 0; m < 4; ++m)
#pragma unroll
                for (int bj = 0; bj < 2; ++bj) {
                    const size_t off = (size_t)(row0 + ai * HALF + m * 16) * 1024 + col0 + bj * HALF;
                    const u32x4 aw = *(const u32x4*)(GA + off), bw = *(const u32x4*)(GB + off);
                    float ga[8], gb[8];
                    ga[0] = bflo(aw.x); ga[1] = bfhi(aw.x); ga[2] = bflo(aw.y); ga[3] = bfhi(aw.y); ga[4] = bflo(aw.z); ga[5] = bfhi(aw.z); ga[6] = bflo(aw.w); ga[7] = bfhi(aw.w);
                    gb[0] = bflo(bw.x); gb[1] = bfhi(bw.x); gb[2] = bflo(bw.y); gb[3] = bfhi(bw.y); gb[4] = bflo(bw.z); gb[5] = bfhi(bw.z); gb[6] = bflo(bw.w); gb[7] = bfhi(bw.w);
#pragma unroll
                    for (int e = 0; e < 8; ++e) {
                        const float ea = __expf(-clampf(ga[e], -30.f, 30.f)), eb = __expf(-clampf(gb[e], -30.f, 30.f));
                        const float ratio = (1.0f + eb) * __builtin_amdgcn_rcpf(1.0f + ea);
                        if (e < 4) acc[ai][bj][m][0][e] *= ratio; else acc[ai][bj][m][1][e - 4] *= ratio;
                    }
                    asm volatile("" : "+v"(acc[ai][bj][m][0]), "+v"(acc[ai][bj][m][1]) :: "memory");
                }
    }
    __device__ __forceinline__ void operator()(const f32x4 (&acc)[2][2][4][2], const Unit& u, int wr, int wc, int fr, int fq) const {
        const int row0 = u.pm * BM + wr * 64 + fr, col0 = u.pn * BM + wc * 32 + 8 * fq;
#pragma unroll
        for (int ai = 0; ai < 2; ++ai)
#pragma unroll
            for (int m = 0; m < 4; ++m)
#pragma unroll
                for (int bj = 0; bj < 2; ++bj) {
                    const size_t off = (size_t)(row0 + ai * HALF + m * 16) * 1024 + col0 + bj * HALF;
                    const u32x4 bw = *(const u32x4*)(GB + off);
                    float gb[8]; gb[0] = bflo(bw.x); gb[1] = bfhi(bw.x); gb[2] = bflo(bw.y); gb[3] = bfhi(bw.y); gb[4] = bflo(bw.z); gb[5] = bfhi(bw.z); gb[6] = bflo(bw.w); gb[7] = bfhi(bw.w);
                    f32x4 v0 = acc[ai][bj][m][0], v1 = acc[ai][bj][m][1];
#pragma unroll
                    for (int e = 0; e < 4; ++e) { v0[e] *= sigm(clampf(gb[e], -30.f, 30.f)); v1[e] *= sigm(clampf(gb[4 + e], -30.f, 30.f)); }
                    u32x4 o; o.x = cvt_pk_bf16(v0[0], v0[1]); o.y = cvt_pk_bf16(v0[2], v0[3]); o.z = cvt_pk_bf16(v1[0], v1[1]); o.w = cvt_pk_bf16(v1[2], v1[3]);
                    *(u32x4*)(MG + off) = o;
                    asm volatile("" ::: "memory");
                }
    }
};
struct EpiResid {
    static constexpr bool PERM = false, AFTER_DRAIN = false, HAS_MID = false;
    const float* X; float* R;
    __device__ __forceinline__ void operator()(const f32x4 (&acc)[2][2][4][2], const Unit& u, int wr, int wc, int fr, int fq) const {
        const int row0 = u.pm * BM + wr * 64 + fr, col0 = u.pn * BM + wc * 32 + 4 * fq;
#pragma unroll
        for (int ai = 0; ai < 2; ++ai)
#pragma unroll
            for (int m = 0; m < 4; ++m) { const size_t off = (size_t)(row0 + ai * HALF + m * 16) * 1024 + col0;
#pragma unroll
                for (int bj = 0; bj < 2; ++bj)
#pragma unroll
                    for (int n = 0; n < 2; ++n) { const f32x4 xv = *(const f32x4*)(X + off + bj * HALF + n * 16); *(f32x4*)(R + off + bj * HALF + n * 16) = xv * 1.189207115002721f + acc[ai][bj][m][n]; } }
    }
};
}

__device__ __forceinline__ void ln_rows(const Frame& F, float* out, const float* lw, const float* lb) {
    const int gw = F.vcu * NWAVES + F.wave, NGW = F.G * NWAVES;
    f32x4 wv[4], bv[4];
#pragma unroll
    for (int j = 0; j < 4; ++j) { wv[j] = *((const GAS f32x4*)lw + F.lane + 64 * j); bv[j] = *((const GAS f32x4*)lb + F.lane + 64 * j); }
    for (int m = gw; m < M; m += NGW) {
        GAS f32x4* xr = (GAS f32x4*)(out + (size_t)m * D) + F.lane;
        f32x4 v[4]; float s = 0.f;
#pragma unroll
        for (int j = 0; j < 4; ++j) { v[j] = xr[64 * j]; s += (v[j].x + v[j].y) + (v[j].z + v[j].w); }
        const float mean = wave_sum(s) * (1.f / D); float s2 = 0.f;
#pragma unroll
        for (int j = 0; j < 4; ++j) { v[j] = v[j] - mean; s2 += (v[j].x * v[j].x + v[j].y * v[j].y) + (v[j].z * v[j].z + v[j].w * v[j].w); }
        const float rstd = 1.f / sqrtf(wave_sum(s2) * (1.f / D) + LN_EPS);
#pragma unroll
        for (int j = 0; j < 4; ++j) xr[64 * j] = v[j] * rstd * wv[j] + bv[j];
    }
}

__global__ void __launch_bounds__(NWAVES * 64, 2) hyb_fwd(Args args) {
    extern __shared__ __attribute__((aligned(16))) unsigned char lds[];
    Frame F;
    F.lds = (LAS unsigned char*)lds;
    volatile LAS unsigned* MISC = (volatile LAS unsigned*)(F.lds + MISC_OFF);
    F.tid = threadIdx.x; F.lane = F.tid & 63; F.wave = __builtin_amdgcn_readfirstlane(F.tid >> 6);
    F.G = gridDim.x; { const int bx = blockIdx.x; F.vcu = (F.G % 8 == 0) ? (bx % 8) * (F.G / 8) + bx / 8 : bx; }
    unsigned char* ws = args.ws;
    gu32* ctl = (gu32*)(ws + WS_CTL);
    if (F.tid < 32) MISC[F.tid] = 0u;
    __syncthreads();
    XcdBarrier bar = xcd_barrier_post((unsigned*)(ctl + CW_BAR), MISC + 8);
#define GRID_BAR() xcd_barrier(bar)

#ifndef NO_P0
    p0_prologue(F, args);
#endif
    GRID_BAR();

#ifndef NO_P1
    {
        pg8::Gemm g{(const bf16*)((unsigned char*)args.out + DO_XB), (const bf16*)(ws + WS_WIN), 1024, 1024, 1024, 0};
        pg8::StaticOrder S; S.init(M, N1, F.G, (int)blockIdx.x);
        pg8::EpiBf16<0> E{(bf16*)(ws + WS_T0), 1024, nullptr, 1024, (size_t)(TS / 2), 1.f};
        pg8::gemm_phase<pg8::EpiBf16<0>, pg8::StaticOrder, true, true>(F.lds, g, S, E);
    }
#endif
    GRID_BAR();

#ifndef NO_P2A1
    pool_elementwise(F, (const bf16*)(ws + WS_U), (bf16*)((unsigned char*)args.out + DO_PP));
#endif
#ifndef NO_P2A2
    for (int u = F.vcu; u < 1024; u += F.G) prep_unit(F, args, u);
#endif
    GRID_BAR();

#ifndef NO_SCAN
    if (blockIdx.x < 32) gla_scan(F, args, (int)blockIdx.x);
    else
#endif
#ifndef NO_PGEMM
    {
        pg8::Gemm g{(const bf16*)((unsigned char*)args.out + DO_PP), (const bf16*)(ws + WS_WP), 256, 1024, 256, 256};
        pg8::StaticOrder S; S.init(M, 1024, F.G - 32, (int)blockIdx.x - 32);
        pg8::EpiYb E{(const bf16*)(ws + WS_Z), (bf16*)(ws + WS_YAB), args.in[6], args.in[7]};
        pg8::gemm_phase<pg8::EpiYb, pg8::StaticOrder, true, true>(F.lds, g, S, E);
    }
#endif
    GRID_BAR();

#ifndef NO_P3
    {
        pg8::Gemm g{(const bf16*)(ws + WS_YAB), (const bf16*)(ws + WS_WAB), 2048, 2048, 2048, 0};
        pg8::StaticOrder S; S.init(M, 1024, F.G, (int)blockIdx.x);
        pg8::EpiMerge E{(const bf16*)(ws + WS_GA), (const bf16*)(ws + WS_GB), (bf16*)(ws + WS_MG)};
        pg8::gemm_phase<pg8::EpiMerge, pg8::StaticOrder, true, true>(F.lds, g, S, E);
    }
#endif
    GRID_BAR();

#ifndef NO_P4
    {
        pg8::Gemm g{(const bf16*)(ws + WS_MG), (const bf16*)(ws + WS_WO), 1024, 1024, 1024, 0};
        pg8::StaticOrder S; S.init(M, 1024, F.G, (int)blockIdx.x);
        pg8::EpiResid E{args.in[0], args.out};
        pg8::gemm_phase<pg8::EpiResid, pg8::StaticOrder, true, true>(F.lds, g, S, E);
    }
#endif
    GRID_BAR();

    ln_rows(F, args.out, args.in[11], args.in[12]);
#undef GRID_BAR
}

extern "C" void kernel_launch(void* const* d_in, const int* in_sizes, int n_in, void* d_out, int out_size, void* d_ws, size_t ws_size, hipStream_t stream) {
    static int grid = 0;
    if (grid == 0) {
        if (n_in != 13 || in_sizes[0] != M * D || out_size != M * D || ws_size < WS_END) { fprintf(stderr, "kernel_launch: unexpected shapes / workspace (%d inputs, in0 %d, out %d, ws %zu)\n", n_in, n_in > 0 ? in_sizes[0] : -1, out_size, ws_size); grid = -1; return; }
        int dev = 0, cus = 0;
        if (hipGetDevice(&dev) != hipSuccess || hipDeviceGetAttribute(&cus, hipDeviceAttributeMultiprocessorCount, dev) != hipSuccess) { grid = -1; return; }
        if (hipFuncSetAttribute((const void*)hyb_fwd, hipFuncAttributeMaxDynamicSharedMemorySize, LDS_BYTES) != hipSuccess) { fprintf(stderr, "kernel_launch: hipFuncSetAttribute failed\n"); grid = -1; return; }
        grid = cus;
        if (grid != 256) fprintf(stderr, "kernel_launch: %d CUs (expected 256)\n", grid);
    }
    if (grid < 0) return;
    (void)hipMemsetAsync((char*)d_ws + WS_CTL, 0, CTL_ZERO_BYTES, stream);
    Args a{};
    for (int i = 0; i < 13; ++i) a.in[i] = (const float*)d_in[i];
    a.out = (float*)d_out; a.ws = (unsigned char*)d_ws;
    hipLaunchKernelGGL(hyb_fwd, dim3(grid), dim3(NWAVES * 64), LDS_BYTES, stream, a);
}
```

```cpp
#include <hip/hip_runtime.h>
#include <cstdio>
#include <cstdint>

#ifndef REP_P0
#define REP_P0 1
#endif
#ifndef REP_P1
#define REP_P1 1
#endif
#ifndef REP_P2A
#define REP_P2A 1
#endif
#ifndef REP_P2B
#define REP_P2B 1
#endif
#ifndef REP_P3
#define REP_P3 1
#endif
#ifndef REP_P4
#define REP_P4 1
#endif
#ifndef REP_BAR
#define REP_BAR 0
#endif
#ifndef REP_SCAN
#define REP_SCAN 1
#endif
namespace pg8 {
#define PG8_LAS __attribute__((address_space(3)))
typedef unsigned short bf16_t;
typedef short bf16x8 __attribute__((ext_vector_type(8)));
typedef float f32x4 __attribute__((ext_vector_type(4)));
typedef unsigned u32x4 __attribute__((ext_vector_type(4)));
constexpr int BM = 256, BK = 64, HALF = 128, HTB = HALF * BK * 2  , STAGE_BYTES = 8 * HTB, NXCD = 8, WGM = 8;

__host__ __device__ __forceinline__ int lds_byte(int r, int c) { const int st = (r >> 4) * 2 + (c >> 5), rr = r & 15, cc = c & 31, ob = rr * 64 + cc * 2; return st * 1024 + (ob ^ (((ob >> 9) & 1) << 5)); }
__host__ __device__ __forceinline__ void stage_rc(int b, int& R, int& C) { const int st = b / 1024, sb = b % 1024, swz = sb ^ (((sb >> 9) & 1) << 5); R = (st >> 1) * 16 + swz / 64; C = (st & 1) * 32 + (swz % 64) / 2; }
__host__ __device__ __forceinline__ int perm32(int rho) { const int n = rho >> 4, i = rho & 15; return 8 * (i >> 2) + 4 * n + (i & 3); }

struct Unit { int pm, pn; };
struct Gemm { const bf16_t* A; const bf16_t* Bt; int K, lda, ldb, a_pn_cols; };

struct StaticOrder {
    int nM, nN, nwg, G, c;
    __host__ __device__ void init(int M, int N, int G_, int c_) { nM = M / BM; nN = N / BM; nwg = nM * nN; G = G_; c = c_; }
    __host__ __device__ bool next(int i, Unit& u) const {
        const long L = (long)i * G + c; if (L >= nwg) return false;
        int wgid = (int)L; { const int q = nwg / NXCD, r = nwg % NXCD, xcd = wgid % NXCD, off = wgid / NXCD; wgid = (xcd < r ? xcd * (q + 1) : r * (q + 1) + (xcd - r) * q) + off; }
        const int nig = WGM * nN, gid = wgid / nig, fm = gid * WGM, gsz = (nM - fm) < WGM ? (nM - fm) : WGM;
        u.pm = fm + ((wgid % nig) % gsz); u.pn = (wgid % nig) / gsz; return true;
    }
    __device__ __forceinline__ void a_ready(const Unit&) const {}
    __device__ __forceinline__ void done(const Unit&) const {}
};

__device__ __forceinline__ unsigned cvt_pk_bf16(float lo, float hi) { unsigned r; asm volatile("v_cvt_pk_bf16_f32 %0, %1, %2" : "=v"(r) : "v"(lo), "v"(hi)); return r; }
typedef float f32x2 __attribute__((ext_vector_type(2)));
__device__ __forceinline__ f32x2 gelu_pk(f32x2 v) {
    const f32x2 av = __builtin_elementwise_abs(v), d = av * 0.2316418882f + 1.0f;
    f32x2 t; t.x = __builtin_amdgcn_rcpf(d.x); t.y = __builtin_amdgcn_rcpf(d.y);
    f32x2 q = t * 0.5307027145f + (-0.7265760135f); q = q * t + 0.7107068705f; q = q * t + (-0.142248368f); q = q * t + 0.127414796f; q = q * t;
    const f32x2 s = (v * v) * (-0.72134752044f);
    f32x2 e; e.x = __builtin_amdgcn_exp2f(s.x); e.y = __builtin_amdgcn_exp2f(s.y);
    const f32x2 m = v * (q * e), r = v - m;
    f32x2 o; o.x = v.x < 0.f ? m.x : r.x; o.y = v.y < 0.f ? m.y : r.y; return o;
}

template <int ACT  > struct EpiBf16 {
    static constexpr bool PERM = true, AFTER_DRAIN = false, HAS_MID = false; static_assert(ACT == 0 || ACT == 1, "EpiBf16: ACT is 0 (none) or 1 (gelu_pk)");
    bf16_t* O; int ldc; const float* bias; int split_cols; size_t split_stride; float scale0;
    __device__ __forceinline__ void operator()(const f32x4 (&acc)[2][2][4][2], const Unit& u, int wr, int wc, int fr, int fq) const {
        const int row0 = u.pm * BM + wr * 64 + fr; int colt = u.pn * BM; bf16_t* base = O;
        float sc = 1.f; if (split_cols) { const int t = colt / split_cols; base += (size_t)t * split_stride; colt -= t * split_cols; if (t == 0) sc = scale0; }
        const int col0 = colt + wc * 32 + 8 * fq, bcol0 = u.pn * BM + wc * 32 + 8 * fq;
        f32x4 bv[2][2];
#pragma unroll
        for (int bj = 0; bj < 2; ++bj)
#pragma unroll
            for (int n = 0; n < 2; ++n) bv[bj][n] = bias ? *(const f32x4*)(bias + bcol0 + bj * HALF + 4 * n) : (f32x4){0.f, 0.f, 0.f, 0.f};
#pragma unroll
        for (int ai = 0; ai < 2; ++ai)
#pragma unroll
            for (int m = 0; m < 4; ++m) { bf16_t* rowp = base + (size_t)(row0 + ai * HALF + m * 16) * ldc + col0;
#pragma unroll
                for (int bj = 0; bj < 2; ++bj) { f32x4 v0 = acc[ai][bj][m][0] + bv[bj][0], v1 = acc[ai][bj][m][1] + bv[bj][1];
                    if (ACT == 1) { f32x2 a = gelu_pk((f32x2){v0[0], v0[1]}), b = gelu_pk((f32x2){v0[2], v0[3]}), c = gelu_pk((f32x2){v1[0], v1[1]}), d = gelu_pk((f32x2){v1[2], v1[3]});
                        v0 = (f32x4){a.x, a.y, b.x, b.y}; v1 = (f32x4){c.x, c.y, d.x, d.y}; }
                    v0 = v0 * sc; v1 = v1 * sc; u32x4 w; w.x = cvt_pk_bf16(v0[0], v0[1]); w.y = cvt_pk_bf16(v0[2], v0[3]); w.z = cvt_pk_bf16(v1[0], v1[1]); w.w = cvt_pk_bf16(v1[2], v1[3]);
                    *(u32x4*)(rowp + bj * HALF) = w; } }
    }
};

struct PanelStats {
    unsigned* xbuf;
    unsigned* cnt;
    unsigned* tmo;
    int ntn; float eps;
    unsigned code;
    __device__ __forceinline__ bool run(const f32x4 (&v)[2][2][4][2], const Unit& u, int wr, int wc, int fr, int fq, PG8_LAS unsigned char* lds, int wid, int lane) const {
        typedef float f32x2v __attribute__((ext_vector_type(2)));
        PG8_LAS f32x2v* P = (PG8_LAS f32x2v*)lds;
        PG8_LAS f32x2v* S = (PG8_LAS f32x2v*)(lds + 8192);
        PG8_LAS unsigned* flag = (PG8_LAS unsigned*)(lds + 8192 + 2048);
#pragma unroll
        for (int ai = 0; ai < 2; ++ai)
#pragma unroll
            for (int m = 0; m < 4; ++m) {
                float s = 0.f;
#pragma unroll
                for (int bj = 0; bj < 2; ++bj)
#pragma unroll
                    for (int n = 0; n < 2; ++n) { const f32x4 x = v[ai][bj][m][n]; s += (x[0] + x[1]) + (x[2] + x[3]); }
                s += __shfl_xor(s, 16); s += __shfl_xor(s, 32);
                const float mw = s * (1.0f / 64.0f); float q = 0.f;
#pragma unroll
                for (int bj = 0; bj < 2; ++bj)
#pragma unroll
                    for (int n = 0; n < 2; ++n) { const f32x4 d = v[ai][bj][m][n] - mw; q += (d[0] * d[0] + d[1] * d[1]) + (d[2] * d[2] + d[3] * d[3]); }
                q += __shfl_xor(q, 16); q += __shfl_xor(q, 32);
                if (fq == 0) P[(ai * HALF + wr * 64 + m * 16 + fr) * 4 + wc] = (f32x2v){mw, q};
            }
        asm volatile("s_waitcnt lgkmcnt(0)" ::: "memory"); __builtin_amdgcn_s_barrier(); asm volatile("" ::: "memory");
#if defined(BROKEN_EXCHANGE_NO_WAIT)
#warning BROKEN CONTROL BUILD: the row-statistics exchange does not wait; results are wrong by design
        if (blockIdx.x >= 64) { const long long t0_ = clock64(); while (clock64() - t0_ < 60000) __builtin_amdgcn_s_sleep(8); }
#endif
        const int row = wid * 32 + (lane & 31);
        if (lane < 32) {
            const f32x2v a = P[row * 4 + 0], b = P[row * 4 + 1], c = P[row * 4 + 2], d = P[row * 4 + 3];
            const float mt = (a.x + b.x + c.x + d.x) * 0.25f;
            const float da = a.x - mt, db = b.x - mt, dc = c.x - mt, dd = d.x - mt;
            const float m2 = (a.y + b.y) + (c.y + d.y) + 64.0f * ((da * da + db * db) + (dc * dc + dd * dd));
            unsigned long long* slot = (unsigned long long*)xbuf + ((size_t)(u.pm * BM + row) * 4 + u.pn);
            __hip_atomic_store(slot, ((unsigned long long)__float_as_uint(m2) << 32) | __float_as_uint(mt), __ATOMIC_RELAXED, __HIP_MEMORY_SCOPE_AGENT);
        }
        asm volatile("s_waitcnt vmcnt(0)" ::: "memory");
        if (lane == 0) __hip_atomic_fetch_add(cnt + 64 * u.pm, 1u, __ATOMIC_RELAXED, __HIP_MEMORY_SCOPE_AGENT);
        if (wid == 0) {
            bool dead = false; const unsigned long long t0 = __builtin_amdgcn_s_memrealtime(); const unsigned want = 8u * (unsigned)ntn;
            for (;;) {
#if defined(BROKEN_EXCHANGE_NO_WAIT)
                break;
#endif
                if ((unsigned)__builtin_amdgcn_readfirstlane(__hip_atomic_load(cnt + 64 * u.pm, __ATOMIC_RELAXED, __HIP_MEMORY_SCOPE_AGENT)) >= want) break;
                if (__builtin_amdgcn_s_memrealtime() - t0 > 2000000ull) {
                    if (lane == 0) { unsigned expect = 0u; __hip_atomic_compare_exchange_strong(tmo + 1, &expect, code | (unsigned)(u.pm & 0xff), __ATOMIC_RELAXED, __ATOMIC_RELAXED, __HIP_MEMORY_SCOPE_AGENT);
                                     __hip_atomic_store(tmo, 1u, __ATOMIC_RELAXED, __HIP_MEMORY_SCOPE_AGENT); }
                    dead = true; break; }
                __builtin_amdgcn_s_sleep(2);
            }
            __builtin_amdgcn_fence(__ATOMIC_ACQUIRE, "agent");
            if (lane == 0) flag[0] = dead ? 1u : 0u;
        }
        asm volatile("s_waitcnt vmcnt(0) lgkmcnt(0)" ::: "memory"); __builtin_amdgcn_s_barrier(); asm volatile("" ::: "memory");
        const bool bad = flag[0] != 0u;
        if (lane < 32) {
            const unsigned long long* slot = (const unsigned long long*)xbuf + (size_t)(u.pm * BM + row) * 4; float mt[4], m2[4]; float ms = 0.f;
#pragma unroll
            for (int t = 0; t < 4; ++t) { if (t < ntn) { const unsigned long long w = __hip_atomic_load(slot + t, __ATOMIC_RELAXED, __HIP_MEMORY_SCOPE_AGENT); mt[t] = __uint_as_float((unsigned)w); m2[t] = __uint_as_float((unsigned)(w >> 32)); } else { mt[t] = 0.f; m2[t] = 0.f; } ms += mt[t]; }
            const float mean = ms / (float)ntn; float q = 0.f;
#pragma unroll
            for (int t = 0; t < 4; ++t) if (t < ntn) { const float dm = mt[t] - mean; q += m2[t] + 256.0f * dm * dm; }
            S[row] = (f32x2v){mean, 1.0f / sqrtf(q / (256.0f * (float)ntn) + eps)};
        }
        asm volatile("s_waitcnt lgkmcnt(0)" ::: "memory"); __builtin_amdgcn_s_barrier(); asm volatile("" ::: "memory");
        return bad;
    }
};
struct EpiLnRes {
    static constexpr bool PERM = false, AFTER_DRAIN = true, HAS_MID = false;
    const float* base; float* out; int ldc; const float* bias; PanelStats st; unsigned poison;
    __device__ __forceinline__ void fused(f32x4 (&acc)[2][2][4][2], const Unit& u, int wr, int wc, int fr, int fq, PG8_LAS unsigned char* lds, int wid, int lane) const {
        typedef float f32x2v __attribute__((ext_vector_type(2)));
        const PG8_LAS f32x2v* S = (const PG8_LAS f32x2v*)(lds + 8192);
        const int col0 = u.pn * BM + wc * 32 + 4 * fq;
#pragma unroll
        for (int bj = 0; bj < 2; ++bj)
#pragma unroll
            for (int n = 0; n < 2; ++n) { const f32x4 bv = bias ? *(const f32x4*)(bias + col0 + bj * HALF + n * 16) : (f32x4){0.f, 0.f, 0.f, 0.f};
#pragma unroll
                for (int ai = 0; ai < 2; ++ai)
#pragma unroll
                    for (int m = 0; m < 4; ++m) acc[ai][bj][m][n] += bv; }
        f32x4 pre[4][2][2];
#pragma unroll
        for (int m = 0; m < 4; ++m) { const size_t off = (size_t)(u.pm * BM + wr * 64 + m * 16 + fr) * ldc + col0;
#pragma unroll
            for (int bj = 0; bj < 2; ++bj)
#pragma unroll
                for (int n = 0; n < 2; ++n) pre[m][bj][n] = *(const f32x4*)(base + off + bj * HALF + n * 16); }
        const bool bad = st.run(acc, u, wr, wc, fr, fq, lds, wid, lane) || poison != 0u;
        const float qnan = __builtin_nanf("");
#pragma unroll
        for (int ai = 0; ai < 2; ++ai)
#pragma unroll
            for (int m = 0; m < 4; ++m) { const int r = ai * HALF + wr * 64 + m * 16 + fr; const f32x2v sr = S[r]; const size_t off = (size_t)(u.pm * BM + r) * ldc + col0;
#pragma unroll
                for (int bj = 0; bj < 2; ++bj)
#pragma unroll
                    for (int n = 0; n < 2; ++n) { const f32x4 bs = ai == 0 ? pre[m][bj][n] : *(const f32x4*)(base + off + bj * HALF + n * 16); f32x4 o = bs + (acc[ai][bj][m][n] - sr.x) * sr.y;
                        if (bad) o = (f32x4){qnan, qnan, qnan, qnan}; *(f32x4*)(out + off + bj * HALF + n * 16) = o; }
                if (m & 1) asm volatile("" ::: "memory"); }
    }
};
struct EpiLnResLn {
    static constexpr bool PERM = false, AFTER_DRAIN = true, HAS_MID = false;
    const float* base; float* out; bf16_t* xn; int ldc; const float* bias; PanelStats st1, st2; unsigned poison;
    __device__ __forceinline__ void fused(f32x4 (&acc)[2][2][4][2], const Unit& u, int wr, int wc, int fr, int fq, PG8_LAS unsigned char* lds, int wid, int lane) const {
        typedef float f32x2v __attribute__((ext_vector_type(2))); typedef unsigned u32x2v __attribute__((ext_vector_type(2)));
        const PG8_LAS f32x2v* S = (const PG8_LAS f32x2v*)(lds + 8192);
        const int col0 = u.pn * BM + wc * 32 + 4 * fq;
#pragma unroll
        for (int bj = 0; bj < 2; ++bj)
#pragma unroll
            for (int n = 0; n < 2; ++n) { const f32x4 bv = bias ? *(const f32x4*)(bias + col0 + bj * HALF + n * 16) : (f32x4){0.f, 0.f, 0.f, 0.f};
#pragma unroll
                for (int ai = 0; ai < 2; ++ai)
#pragma unroll
                    for (int m = 0; m < 4; ++m) acc[ai][bj][m][n] += bv; }
        bool bad = st1.run(acc, u, wr, wc, fr, fq, lds, wid, lane) || poison != 0u;
        const float qnan = __builtin_nanf("");
#pragma unroll
        for (int ai = 0; ai < 2; ++ai)
#pragma unroll
            for (int m = 0; m < 4; ++m) { const int r = ai * HALF + wr * 64 + m * 16 + fr; const f32x2v sr = S[r]; const size_t off = (size_t)(u.pm * BM + r) * ldc + col0;
#pragma unroll
                for (int bj = 0; bj < 2; ++bj)
#pragma unroll
                    for (int n = 0; n < 2; ++n) { const f32x4 bs = *(const f32x4*)(base + off + bj * HALF + n * 16); acc[ai][bj][m][n] = bs + (acc[ai][bj][m][n] - sr.x) * sr.y; }
                asm volatile("" : "+v"(acc[ai][0][m][0]), "+v"(acc[ai][0][m][1]), "+v"(acc[ai][1][m][0]), "+v"(acc[ai][1][m][1]));
                if (m & 1) asm volatile("" ::: "memory"); }
        const bool bad1 = bad;
        bad = st2.run(acc, u, wr, wc, fr, fq, lds, wid, lane) || bad;
#pragma unroll
        for (int ai = 0; ai < 2; ++ai)
#pragma unroll
            for (int m = 0; m < 4; ++m) { const int r = ai * HALF + wr * 64 + m * 16 + fr; const f32x2v sr = S[r]; const size_t off = (size_t)(u.pm * BM + r) * ldc + col0;
#pragma unroll
                for (int bj = 0; bj < 2; ++bj)
#pragma unroll
                    for (int n = 0; n < 2; ++n) { const f32x4 x1 = acc[ai][bj][m][n]; *(f32x4*)(out + off + bj * HALF + n * 16) = bad1 ? (f32x4){qnan, qnan, qnan, qnan} : x1;
                        const f32x4 o = (x1 - sr.x) * sr.y; u32x2v w; w.x = cvt_pk_bf16(o[0], o[1]); w.y = cvt_pk_bf16(o[2], o[3]);
                        if (bad) { w.x = 0x7fc07fc0u; w.y = 0x7fc07fc0u; } *(u32x2v*)(xn + off + bj * HALF + n * 16) = w; }
                asm volatile("" ::: "memory"); }
    }
};

template <class Epi, class Sched, bool ALIGN_EPI = false, bool SP2 = false>
__device__ __forceinline__ void gemm_phase(PG8_LAS unsigned char* lds, const Gemm g, const Sched& S, const Epi& E) {
    const int tid = threadIdx.x, wid = __builtin_amdgcn_readfirstlane(tid >> 6), lane = tid & 63, wr = wid >> 2, wc = wid & 3, fr = lane & 15, fq = lane >> 4;
    const int K = g.K, nt = K / BK;
    unsigned voffA[2], voffB[2];
#pragma unroll
    for (int i = 0; i < 2; ++i) { int R, C; stage_rc(tid * 16 + i * 8192, R, C); const int Rb = Epi::PERM ? ((R & ~31) + perm32(R & 31)) : R;
        voffA[i] = (unsigned)(R * g.lda + C) * 2u; voffB[i] = (unsigned)(Rb * g.ldb + C) * 2u; }
    const size_t kstep = (size_t)(BK * 2);
    const size_t hstepA = (size_t)HALF * g.lda * 2, hstepB = (size_t)HALF * g.ldb * 2;
    const size_t tstepA = 2 * hstepA, tstepB = 2 * hstepB;
    const size_t pnA = (size_t)g.a_pn_cols * 2;
    const unsigned ldsw = (unsigned)wid * 1024u;
    const int aoff = lds_byte(wr * 64 + fr, fq * 8), boff = lds_byte(wc * 32 + fr, fq * 8);
#define PG8_SA(b, h) (((b) * 2 + (h)) * HTB)
#define PG8_SB(b, h) ((4 + (b) * 2 + (h)) * HTB)
#define PG8_STAGE(bufoff, gbase, voff) do { _Pragma("unroll") for (int _i = 0; _i < 2; ++_i) \
        __builtin_amdgcn_global_load_lds((const unsigned*)((const char*)(gbase) + (voff)[_i]), (PG8_LAS unsigned*)(lds + (bufoff) + ldsw + _i * 8192), 16, 0, 0); } while (0)
#define PG8_LDA(dst, b, h) do { _Pragma("unroll") for (int m = 0; m < 4; ++m) _Pragma("unroll") for (int k = 0; k < 2; ++k) dst[m][k] = *(const PG8_LAS bf16x8*)(lds + PG8_SA(b, h) + aoff + m * 2048 + k * 1024); } while (0)
#define PG8_LDB(dst, b, h) do { _Pragma("unroll") for (int n = 0; n < 2; ++n) _Pragma("unroll") for (int k = 0; k < 2; ++k) dst[n][k] = *(const PG8_LAS bf16x8*)(lds + PG8_SB(b, h) + boff + n * 2048 + k * 1024); } while (0)
#define PG8_MMA(ai, bj, At, Bt) do { __builtin_amdgcn_s_setprio(1); _Pragma("unroll") for (int m = 0; m < 4; ++m) _Pragma("unroll") for (int n = 0; n < 2; ++n) _Pragma("unroll") for (int k = 0; k < 2; ++k) \
        acc[ai][bj][m][n] = __builtin_amdgcn_mfma_f32_16x16x32_bf16(Bt[n][k], At[m][k], acc[ai][bj][m][n], 0, 0, 0); __builtin_amdgcn_s_setprio(0); } while (0)
#define PG8_WAIT_V(n) asm volatile("s_waitcnt vmcnt(" #n ")" ::: "memory")
#define PG8_WAIT_L(n) asm volatile("s_waitcnt lgkmcnt(" #n ")" ::: "memory")
#define PG8_BAR __builtin_amdgcn_s_barrier()
#define PG8_SCHED __builtin_amdgcn_sched_barrier(0)
    Unit cur, nxt; int ui = 0;
    if (!S.next(0, cur)) return;
    f32x4 acc[2][2][4][2];
#pragma unroll
    for (int a = 0; a < 2; ++a)
#pragma unroll
        for (int b = 0; b < 2; ++b)
#pragma unroll
            for (int m = 0; m < 4; ++m)
#pragma unroll
                for (int n = 0; n < 2; ++n) acc[a][b][m][n] = (f32x4){0.f, 0.f, 0.f, 0.f};
    bf16x8 At[4][2], B0[2][2], B1[2][2];
    const char* cA = (const char*)g.A + (size_t)cur.pm * tstepA + (size_t)cur.pn * pnA; const char* cB = (const char*)g.Bt + (size_t)cur.pn * tstepB;
    S.a_ready(cur);
    if constexpr (SP2) {
        PG8_STAGE(PG8_SB(0, 0), cB, voffB); PG8_STAGE(PG8_SB(0, 1), cB + hstepB, voffB); PG8_STAGE(PG8_SA(0, 0), cA, voffA); PG8_STAGE(PG8_SA(0, 1), cA + hstepA, voffA);
        if (wr == 1) PG8_BAR;
        PG8_WAIT_V(2); PG8_BAR;
        PG8_STAGE(PG8_SB(1, 0), cB + kstep, voffB); PG8_STAGE(PG8_SA(1, 0), cA + kstep, voffA); PG8_STAGE(PG8_SB(1, 1), cB + hstepB + kstep, voffB);
        PG8_WAIT_V(6); PG8_BAR;
    } else {
        PG8_STAGE(PG8_SB(0, 0), cB, voffB); PG8_STAGE(PG8_SA(0, 0), cA, voffA); PG8_STAGE(PG8_SB(0, 1), cB + hstepB, voffB); PG8_STAGE(PG8_SA(0, 1), cA + hstepA, voffA);
        if (wr == 1) PG8_BAR;
        PG8_WAIT_V(4); PG8_BAR;
        PG8_STAGE(PG8_SB(1, 0), cB + kstep, voffB); PG8_STAGE(PG8_SA(1, 0), cA + kstep, voffA); PG8_STAGE(PG8_SB(1, 1), cB + hstepB + kstep, voffB);
        PG8_WAIT_V(6); PG8_BAR;
    }
    for (;;) {
        const bool has_next = S.next(ui + 1, nxt);
        const char* nA = has_next ? (const char*)g.A + (size_t)nxt.pm * tstepA + (size_t)nxt.pn * pnA : cA; const char* nB = has_next ? (const char*)g.Bt + (size_t)nxt.pn * tstepB : cB;
#pragma unroll 1
        for (int seg = 0; seg < (Epi::HAS_MID ? 2 : 1); ++seg) {
        if constexpr (Epi::HAS_MID) { if (seg) E.mid_big(acc, cur, wr, wc, fr, fq); }
        const int t_beg = (Epi::HAS_MID && seg) ? nt / 2 : 0, t_end = (Epi::HAS_MID && !seg) ? nt / 2 : nt;
#pragma unroll 1
        for (int t = t_beg; t < t_end; t += 2) {
            const bool last = (t == nt - 2);
            const char* a1 = cA + (size_t)(t + 1) * kstep;
            const char* a2 = last ? nA : cA + (size_t)(t + 2) * kstep; const char* b2 = last ? nB : cB + (size_t)(t + 2) * kstep;
            const char* a3 = a2 + kstep; const char* b3 = b2 + kstep;
            if (last && has_next) S.a_ready(nxt);
            if constexpr (Epi::HAS_MID) { if ((t & 3) == 0 && t != 0 && t < nt / 2) E.mid(t, acc, cur, wr, wc, fr, fq); }
            if constexpr (SP2) {
            PG8_LDB(B0, 0, 0); PG8_LDB(B1, 0, 1); PG8_SCHED; PG8_LDA(At, 0, 0); PG8_STAGE(PG8_SA(1, 1), a1 + hstepA, voffA);
            PG8_WAIT_V(8); PG8_WAIT_L(0); PG8_BAR; PG8_MMA(0, 0, At, B0); PG8_MMA(0, 1, At, B1); PG8_BAR; PG8_SCHED;
            PG8_LDA(At, 0, 1); PG8_STAGE(PG8_SB(0, 0), b2, voffB); PG8_STAGE(PG8_SB(0, 1), b2 + hstepB, voffB); PG8_STAGE(PG8_SA(0, 0), a2, voffA);
            PG8_WAIT_V(8); PG8_WAIT_L(0); PG8_BAR; PG8_MMA(1, 0, At, B0); PG8_MMA(1, 1, At, B1); PG8_BAR; PG8_SCHED;
            PG8_LDB(B0, 1, 0); PG8_LDB(B1, 1, 1); PG8_SCHED; PG8_LDA(At, 1, 0); PG8_STAGE(PG8_SA(0, 1), a2 + hstepA, voffA);
            PG8_WAIT_V(8); PG8_WAIT_L(0); PG8_BAR; PG8_MMA(0, 0, At, B0); PG8_MMA(0, 1, At, B1); PG8_BAR; PG8_SCHED;
            PG8_LDA(At, 1, 1); PG8_STAGE(PG8_SB(1, 0), b3, voffB); PG8_STAGE(PG8_SB(1, 1), b3 + hstepB, voffB); PG8_STAGE(PG8_SA(1, 0), a3, voffA);
            PG8_WAIT_V(8); PG8_WAIT_L(0); PG8_BAR; PG8_MMA(1, 0, At, B0); PG8_MMA(1, 1, At, B1); PG8_BAR; PG8_SCHED;
            } else {
            PG8_LDB(B0, 0, 0); PG8_SCHED; PG8_LDA(At, 0, 0); PG8_STAGE(PG8_SA(1, 1), a1 + hstepA, voffA);
            PG8_WAIT_L(8); PG8_BAR; PG8_WAIT_L(0); PG8_MMA(0, 0, At, B0); PG8_BAR; PG8_SCHED;
            PG8_LDB(B1, 0, 1); PG8_STAGE(PG8_SB(0, 0), b2, voffB);
            PG8_BAR; PG8_WAIT_L(0); PG8_MMA(0, 1, At, B1); PG8_BAR;
            PG8_LDA(At, 0, 1); PG8_STAGE(PG8_SA(0, 0), a2, voffA);
            PG8_BAR; PG8_WAIT_L(0); PG8_MMA(1, 0, At, B0); PG8_BAR; PG8_SCHED;
            PG8_STAGE(PG8_SB(0, 1), b2 + hstepB, voffB);
            PG8_WAIT_V(6); PG8_BAR; PG8_MMA(1, 1, At, B1); PG8_BAR;
            PG8_LDB(B0, 1, 0); PG8_SCHED; PG8_LDA(At, 1, 0); PG8_STAGE(PG8_SA(0, 1), a2 + hstepA, voffA);
            PG8_WAIT_L(8); PG8_BAR; PG8_WAIT_L(0); PG8_MMA(0, 0, At, B0); PG8_BAR; PG8_SCHED;
            PG8_LDB(B1, 1, 1); PG8_STAGE(PG8_SB(1, 0), b3, voffB);
            PG8_BAR; PG8_WAIT_L(0); PG8_MMA(0, 1, At, B1); PG8_BAR;
            PG8_LDA(At, 1, 1); PG8_STAGE(PG8_SA(1, 0), a3, voffA);
            PG8_BAR; PG8_WAIT_L(0); PG8_MMA(1, 0, At, B0); PG8_BAR; PG8_SCHED;
            PG8_STAGE(PG8_SB(1, 1), b3 + hstepB, voffB);
            PG8_WAIT_V(6); PG8_BAR; PG8_MMA(1, 1, At, B1); PG8_BAR;
            }
        }
        }
        if constexpr (ALIGN_EPI) { if (wr == 0) PG8_BAR; }
        if constexpr (!Epi::AFTER_DRAIN) { E(acc, cur, wr, wc, fr, fq); S.done(cur); }
        if (!has_next) break;
#pragma unroll
        for (int a = 0; a < 2; ++a)
#pragma unroll
            for (int b = 0; b < 2; ++b)
#pragma unroll
                for (int m = 0; m < 4; ++m)
#pragma unroll
                    for (int n = 0; n < 2; ++n) acc[a][b][m][n] = (f32x4){0.f, 0.f, 0.f, 0.f};
        cur = nxt; cA = nA; cB = nB; ++ui;
        if constexpr (ALIGN_EPI) { if (wr == 1) PG8_BAR; }
    }
    PG8_WAIT_V(0);
    if constexpr (!ALIGN_EPI) { if (wr == 0) PG8_BAR; }
    PG8_BAR;
    if constexpr (Epi::AFTER_DRAIN) { E.fused(acc, cur, wr, wc, fr, fq, lds, wid, lane); S.done(cur); }
#undef PG8_SA
#undef PG8_SB
#undef PG8_STAGE
#undef PG8_LDA
#undef PG8_LDB
#undef PG8_MMA
#undef PG8_WAIT_V
#undef PG8_WAIT_L
#undef PG8_BAR
#undef PG8_SCHED
}
}

constexpr int NWAVES = 8;
constexpr int M = 16384, D = 1024, SEQ = 2048;
constexpr int N1 = 7168;
constexpr int W_IN_LD = 7184;
constexpr float LN_EPS = 1e-5f, RMS_EPS = 1e-5f;
constexpr float ALPHA = 1.189207115002721f;
constexpr float QSCALE = 0.08838834764831845f;

constexpr size_t MiB = 1u << 20;
constexpr size_t WS_CTL = 0, CTL_ZERO_BYTES = 1 * MiB;
constexpr size_t WS_ALOW = 1 * MiB;
constexpr size_t WS_WAB = 2 * MiB;
constexpr size_t WS_WO = 6 * MiB;
constexpr size_t WS_WP = 8 * MiB;
constexpr size_t WS_WIN = 10 * MiB;
constexpr size_t WS_PS = 10 * MiB;
constexpr size_t WS_GD = 18 * MiB;
constexpr size_t WS_T0 = 24 * MiB, TS = 32 * MiB;
constexpr size_t WS_QK = WS_T0, WS_U = WS_T0 + TS, WS_V = WS_T0 + 2 * TS, WS_G = WS_T0 + 3 * TS, WS_Z = WS_T0 + 4 * TS, WS_GA = WS_T0 + 5 * TS, WS_GB = WS_T0 + 6 * TS;
constexpr size_t WS_YAB = WS_T0;
constexpr size_t WS_MG = WS_V;
constexpr size_t WS_SSQP = WS_T0 + 7 * TS;
constexpr size_t WS_END = WS_SSQP + 4 * MiB;
constexpr size_t DO_XB = 0, DO_PP = 0, DO_QE = 32 * MiB, DO_KD = 48 * MiB;

constexpr int CW_TMO = 0, CW_CODE = 1, CW_BAR = 4096;
constexpr int LDS_BYTES = 147456;
constexpr int MISC_OFF = LDS_BYTES - 128;

#define GAS __attribute__((address_space(1)))
#define LAS __attribute__((address_space(3)))
typedef unsigned short bf16;
typedef unsigned v4u __attribute__((ext_vector_type(4)));
typedef unsigned v2u __attribute__((ext_vector_type(2)));
typedef float f32x4 __attribute__((ext_vector_type(4)));
typedef short bf16x8 __attribute__((ext_vector_type(8)));
typedef short s16x4 __attribute__((ext_vector_type(4)));
typedef short v4i16_t __attribute__((ext_vector_type(4)));
typedef GAS unsigned gu32;
#define RLX_AGENT __ATOMIC_RELAXED, __HIP_MEMORY_SCOPE_AGENT
#define LDS_WAIT() asm volatile("s_waitcnt lgkmcnt(0)" ::: "memory")
#define VM_WAIT() asm volatile("s_waitcnt vmcnt(0)" ::: "memory")
__device__ __forceinline__ unsigned f2bf(float f) { unsigned u = __builtin_bit_cast(unsigned, f); return (u + 0x7fffu + ((u >> 16) & 1u)) >> 16; }
__device__ __forceinline__ unsigned pk2(float lo, float hi) { return f2bf(lo) | (f2bf(hi) << 16); }
__device__ __forceinline__ float bf2f(unsigned b) { return __builtin_bit_cast(float, b << 16); }
__device__ __forceinline__ float bflo(unsigned w) { return __builtin_bit_cast(float, w << 16); }
__device__ __forceinline__ float bfhi(unsigned w) { return __builtin_bit_cast(float, w & 0xffff0000u); }
__device__ __forceinline__ float expn(float x) { return __builtin_amdgcn_exp2f(x * -1.4426950408889634f); }
__device__ __forceinline__ float sigm(float x) { return __builtin_amdgcn_rcpf(1.0f + expn(x)); }
__device__ __forceinline__ float clampf(float x, float lo, float hi) { return fminf(fmaxf(x, lo), hi); }

#define XB_TMO      128
#define XB_XCNT(j)  (256  + 64 * (j))
#define XB_XSUB(j)  (1280 + 64 * (j))
#define XB_XGEN(j)  (2304 + 64 * (j))
#define XB_TOP      3328
#define XB_TOPGEN   3392
#define XCD_BAR_WORDS 3456
#define XB_SPIN_CAP (1u << 18)

__device__ __forceinline__ unsigned xb_ld(unsigned* p)              { return __hip_atomic_load(p, __ATOMIC_RELAXED, __HIP_MEMORY_SCOPE_AGENT); }
__device__ __forceinline__ unsigned xb_add(unsigned* p, unsigned v) { return __hip_atomic_fetch_add(p, v, __ATOMIC_RELAXED, __HIP_MEMORY_SCOPE_AGENT); }
__device__ __forceinline__ unsigned xb_xcc_id() { return (unsigned)__builtin_amdgcn_s_getreg((3 << 11) | 20) & 0xFu; }
#define XB_SPIN(cond, bar) do { unsigned _sp = 0; while (cond) { __builtin_amdgcn_s_sleep(1); \
    if ((++_sp & 255u) == 0u) { if (xb_ld(&(bar)[XB_TMO])) break; if (_sp > XB_SPIN_CAP) { atomicAdd(&(bar)[XB_TMO], 1u); break; } } } } while (0)

struct XcdBarrier {
    unsigned* bar; unsigned x;
    volatile LAS unsigned* st;
};

__device__ __forceinline__ XcdBarrier xcd_barrier_post(unsigned* bar, volatile LAS unsigned* st) {
    XcdBarrier b; b.bar = bar; b.x = xb_xcc_id(); b.st = st;
    if (threadIdx.x == 0) (void)xb_add(&bar[XB_XCNT(b.x)], 1u);
    return b;
}
__device__ __forceinline__ void xcd_barrier_complete(unsigned* bar, unsigned x, unsigned& nloc, unsigned& nx) {
    const unsigned G = gridDim.x * gridDim.y * gridDim.z;
    unsigned sum, cnt, mine, sp = 0u;
    for (;;) {
        sum = 0u; cnt = 0u; mine = 0u;
#pragma unroll
        for (unsigned j = 0; j < 16; ++j) { const unsigned c = xb_ld(&bar[XB_XCNT(j)]); sum += c; cnt += (c > 0u) ? 1u : 0u; mine = (j == x) ? c : mine; }
        if (sum == G) break;
        __builtin_amdgcn_s_sleep(1);
        if ((++sp & 255u) == 0u) { if (xb_ld(&bar[XB_TMO])) break; if (sp > XB_SPIN_CAP) { atomicAdd(&bar[XB_TMO], 1u); break; } }
    }
    nloc = mine > 0u ? mine : 1u; nx = cnt > 0u ? cnt : 1u;
}

__device__ __forceinline__ void xcd_barrier(const XcdBarrier& b) {
    asm volatile("s_waitcnt vmcnt(0)" ::: "memory");
    __syncthreads();
    if (threadIdx.x == 0) {
        unsigned* bar = b.bar;
        __builtin_amdgcn_s_waitcnt(0);
        unsigned nloc = b.st[0], nx = b.st[1];
        if (nloc == 0u) { xcd_barrier_complete(bar, b.x, nloc, nx); b.st[0] = nloc; b.st[1] = nx; }
        const unsigned old = xb_add(&bar[XB_XSUB(b.x)], 1u);
        const unsigned gen = old / nloc;
        if (old + 1u == (gen + 1u) * nloc) {
            __builtin_amdgcn_fence(__ATOMIC_RELEASE, "agent");
            asm volatile("s_waitcnt vmcnt(0)" ::: "memory");
            const unsigned og = xb_add(&bar[XB_TOP], 1u);
            const unsigned tg = og / nx;
            if (og + 1u == (tg + 1u) * nx) xb_add(&bar[XB_TOPGEN], 1u);
            else XB_SPIN(xb_ld(&bar[XB_TOPGEN]) == tg, bar);
            __builtin_amdgcn_fence(__ATOMIC_ACQUIRE, "agent");
            xb_add(&bar[XB_XGEN(b.x)], 1u);
            asm volatile("s_waitcnt vmcnt(0)" ::: "memory");
        } else {
            XB_SPIN(xb_ld(&bar[XB_XGEN(b.x)]) == gen, bar);
            __builtin_amdgcn_fence(__ATOMIC_ACQUIRE, "agent");
            asm volatile("s_waitcnt vmcnt(0)" ::: "memory");
        }
    }
    __syncthreads();
}


struct Args { const float* in[13]; float* out; unsigned char* ws; };
struct Frame { LAS unsigned char* lds; int tid, lane, wave, vcu, G; };

__device__ __forceinline__ float wave_sum(float v) {
#pragma unroll
    for (int o = 1; o < 64; o <<= 1) v += __shfl_xor(v, o);
    return v;
}

__device__ __forceinline__ void p0_transpose_item(const float* W, int ldw, int scol0, bf16* WT, int ldt, int drow0, int dkoff, LAS float* scr, int kb, int nb, int lane) {
    const int k0 = 64 * kb, n0 = 32 * nb;
#pragma unroll 8
    for (int i = 0; i < 32; ++i) { const int kk = 2 * i + (lane >> 5); scr[kk * 33 + (lane & 31)] = W[(size_t)(k0 + kk) * ldw + scol0 + n0 + (lane & 31)]; }
    LDS_WAIT(); asm volatile("" ::: "memory");
    const int c = lane & 7;
#pragma unroll
    for (int j = 0; j < 4; ++j) { const int n = (lane >> 3) + 8 * j; const LAS float* s = scr + (8 * c) * 33 + n;
        v4u o; o.x = pk2(s[0 * 33], s[1 * 33]); o.y = pk2(s[2 * 33], s[3 * 33]); o.z = pk2(s[4 * 33], s[5 * 33]); o.w = pk2(s[6 * 33], s[7 * 33]);
        *(GAS v4u*)(WT + (size_t)(drow0 + n0 + n) * ldt + dkoff + k0 + 8 * c) = o; }
    LDS_WAIT(); asm volatile("" ::: "memory");
}

__device__ __forceinline__ void p0_prologue(const Frame& F, const Args& a) {
    unsigned char* ws = a.ws;
    const float* x = a.in[0]; const float* w_in = a.in[1]; const float* pool_w = a.in[5]; const float* w_a = a.in[8]; const float* w_b = a.in[9]; const float* w_o = a.in[10];
    bf16* WIN = (bf16*)(ws + WS_WIN); bf16* WAB = (bf16*)(ws + WS_WAB); bf16* WO = (bf16*)(ws + WS_WO); bf16* WP = (bf16*)(ws + WS_WP);
    LAS float* scr = (LAS float*)(F.lds + F.wave * 16384);
    const int gw = F.vcu * NWAVES + F.wave, NGW = F.G * NWAVES;
    constexpr int NBIG = 10 * 512, NITEMS = NBIG + 4 * 32;
    for (int it = gw; it < NITEMS; it += NGW) {
        if (it < NBIG) {
            const int seg = it >> 9, r = it & 511, kb = r >> 5, nb = r & 31;
            if (seg < 7) {
                const int scol0 = seg == 0 ? 0 : seg == 1 ? 3088 : seg == 2 ? 1024 : seg == 3 ? 2048 : seg == 4 ? 4112 : seg == 5 ? 5136 : 6160;
                p0_transpose_item(w_in, W_IN_LD, scol0, WIN, 1024, 1024 * seg, 0, scr, kb, nb, F.lane);
            } else if (seg == 7) p0_transpose_item(w_a, 1024, 0, WAB, 2048, 0, 0, scr, kb, nb, F.lane);
            else if (seg == 8) p0_transpose_item(w_b, 1024, 0, WAB, 2048, 0, 1024, scr, kb, nb, F.lane);
            else p0_transpose_item(w_o, 1024, 0, WO, 1024, 0, 0, scr, kb, nb, F.lane);
        } else {
            const int r0 = it - NBIG, g = r0 >> 5, r = r0 & 31, kb = r >> 3, nb = r & 7;
            p0_transpose_item(pool_w + (size_t)g * 65536, 256, 0, WP + (size_t)g * 65536, 256, 0, 0, scr, kb, nb, F.lane);
        }
    }
    __syncthreads();
    LAS float* wal = (LAS float*)F.lds;
#pragma unroll
    for (int i = 0; i < 2; ++i) { const int k = F.tid + 512 * i; const GAS f32x4* src = (const GAS f32x4*)(w_in + (size_t)k * W_IN_LD + 3072);
#pragma unroll
        for (int q = 0; q < 4; ++q) { const f32x4 v = src[q]; wal[(4 * q + 0) * 1024 + k] = v.x; wal[(4 * q + 1) * 1024 + k] = v.y; wal[(4 * q + 2) * 1024 + k] = v.z; wal[(4 * q + 3) * 1024 + k] = v.w; } }
    __syncthreads();
    bf16* XB = (bf16*)((unsigned char*)a.out + DO_XB); float* ALOW = (float*)(ws + WS_ALOW);
    for (int m = gw; m < M; m += NGW) {
        const GAS f32x4* xr = (const GAS f32x4*)(x + (size_t)m * D) + F.lane;
        f32x4 v[4];
#pragma unroll
        for (int j = 0; j < 4; ++j) v[j] = xr[64 * j];
        GAS unsigned long long* o8 = (GAS unsigned long long*)(XB + (size_t)m * D) + F.lane;
#pragma unroll
        for (int j = 0; j < 4; ++j) o8[64 * j] = (unsigned long long)pk2(v[j].x, v[j].y) | ((unsigned long long)pk2(v[j].z, v[j].w) << 32);
        float acc[16];
#pragma unroll
        for (int r = 0; r < 16; ++r) acc[r] = 0.f;
#pragma unroll
        for (int j = 0; j < 4; ++j)
#pragma unroll
            for (int r = 0; r < 16; ++r) { const f32x4 w = *(const LAS f32x4*)(wal + r * 1024 + 256 * j + 4 * F.lane); acc[r] += (v[j].x * w.x + v[j].y * w.y) + (v[j].z * w.z + v[j].w * w.w);
                if ((r & 3) == 3) asm volatile("" ::: "memory"); }
        float mine = 0.f;
#pragma unroll
        for (int r = 0; r < 16; ++r) { const float s = wave_sum(acc[r]); mine = (F.lane == r) ? s : mine; }
        if (F.lane < 16) ALOW[(size_t)m * 16 + F.lane] = mine;
    }
}

__device__ __forceinline__ void unpack8(const v4u w, float (&f)[8]) { f[0] = bflo(w.x); f[1] = bfhi(w.x); f[2] = bflo(w.y); f[3] = bfhi(w.y); f[4] = bflo(w.z); f[5] = bfhi(w.z); f[6] = bflo(w.w); f[7] = bfhi(w.w); }

__device__ __forceinline__ void pool_elementwise(const Frame& F, const bf16* U, bf16* PP) {
    const int task = F.vcu * 512 + F.tid;
    if (task >= 128 * (M / 16)) return;
    const int c8 = task & 127, strip = task >> 7, grp = c8 >> 5, w = 2 << grp;
    const int r0 = strip * 16, pos0 = r0 & (SEQ - 1);
    const GAS v4u* up = (const GAS v4u*)(U + (size_t)c8 * 8);
    float sum[8];
#pragma unroll
    for (int e = 0; e < 8; ++e) sum[e] = 0.f;
    for (int j = 1; j < w; ++j) if (pos0 - j >= 0) { float f[8]; unpack8(up[(size_t)(r0 - j) * 128], f);
#pragma unroll
        for (int e = 0; e < 8; ++e) sum[e] += f[e]; }
    for (int i = 0; i < 16; ++i) {
        const int row = r0 + i, pos = pos0 + i;
        float f[8]; unpack8(up[(size_t)row * 128], f);
        const int cnt = (pos + 1 < w) ? pos + 1 : w; const float inv = 1.0f / (float)cnt;
        float p[8];
#pragma unroll
        for (int e = 0; e < 8; ++e) { sum[e] += f[e]; p[e] = sum[e] * inv - f[e]; }
        v4u o; o.x = pk2(p[0], p[1]); o.y = pk2(p[2], p[3]); o.z = pk2(p[4], p[5]); o.w = pk2(p[6], p[7]);
        *(GAS v4u*)(PP + (size_t)row * 1024 + c8 * 8) = o;
        if (pos - w + 1 >= 0) { float g[8]; unpack8(up[(size_t)(row - w + 1) * 128], g);
#pragma unroll
            for (int e = 0; e < 8; ++e) sum[e] -= g[e]; }
    }
}

__device__ __forceinline__ float logsigmoid_f(float x) { return fminf(x, 0.f) - __logf(1.0f + __expf(-fabsf(x))); }

__device__ __forceinline__ void prep_unit(const Frame& F, const Args& a, int u) {
    unsigned char* ws = a.ws;
    const int c = u & 31, h = (u >> 5) & 3, b = u >> 7; const int t0 = b * SEQ + 64 * c;
    const float* ALOW = (const float*)(ws + WS_ALOW); const float* Wg = a.in[2]; const float* bg = a.in[3];
    const bf16* QK = (const bf16*)(ws + WS_QK);
    bf16* QE = (bf16*)((unsigned char*)a.out + DO_QE); bf16* KD = (bf16*)((unsigned char*)a.out + DO_KD);
    bf16* PS = (bf16*)(ws + WS_PS) + (size_t)u * 3072; float* GD = (float*)(ws + WS_GD) + (size_t)u * 128;
    LAS float* al = (LAS float*)(F.lds);
    LAS float* tot = (LAS float*)(F.lds + 4096);
    LAS bf16* qeL = (LAS bf16*)(F.lds + 8192);
    LAS bf16* knL = (LAS bf16*)(F.lds + 8192 + 17408);
    __syncthreads();
    if (F.tid < 256) { const f32x4 v = *(const GAS f32x4*)(ALOW + (size_t)(t0 + (F.tid >> 2)) * 16 + (F.tid & 3) * 4); *(LAS f32x4*)(al + (F.tid >> 2) * 16 + (F.tid & 3) * 4) = v; }
    const int k = F.tid & 127, tg = F.tid >> 7;
    float wg[16];
#pragma unroll
    for (int r = 0; r < 16; ++r) wg[r] = Wg[r * 512 + 128 * h + k];
    const float bgk = bg[128 * h + k];
    __syncthreads();
    float bc[16]; float run = 0.f;
#pragma unroll
    for (int i = 0; i < 16; ++i) {
        const LAS f32x4* ap = (const LAS f32x4*)(al + (16 * tg + i) * 16);
        const f32x4 a0 = ap[0], a1 = ap[1], a2 = ap[2], a3 = ap[3];
        float s = bgk;
        s += a0.x * wg[0]; s += a0.y * wg[1]; s += a0.z * wg[2]; s += a0.w * wg[3];
        s += a1.x * wg[4]; s += a1.y * wg[5]; s += a1.z * wg[6]; s += a1.w * wg[7];
        s += a2.x * wg[8]; s += a2.y * wg[9]; s += a2.z * wg[10]; s += a2.w * wg[11];
        s += a3.x * wg[12]; s += a3.y * wg[13]; s += a3.z * wg[14]; s += a3.w * wg[15];
        run += logsigmoid_f(s) * (1.0f / 16.0f); bc[i] = run;
    }
    tot[tg * 128 + k] = run;
    __syncthreads();
    float pre = 0.f, blast = 0.f;
#pragma unroll
    for (int g2 = 0; g2 < 4; ++g2) { const float t = tot[g2 * 128 + k]; blast += t; pre += (g2 < tg) ? t : 0.f; }
#pragma unroll
    for (int i = 0; i < 16; ++i) {
        const int tok = 16 * tg + i; const size_t row = (size_t)(t0 + tok); const float bb = pre + bc[i];
        const float qv = bf2f(QK[row * 1024 + 128 * h + k]), kv = bf2f(QK[row * 1024 + 512 + 128 * h + k]);
        const float qe = qv * QSCALE * __expf(bb), kn = kv * __expf(-bb), kd = kv * __expf(blast - bb);
        const bf16 qeb = (bf16)f2bf(qe);
        QE[row * 512 + 128 * h + k] = qeb; KD[row * 512 + 128 * h + k] = (bf16)f2bf(kd);
        qeL[tok * 136 + k] = qeb; knL[tok * 136 + k] = (bf16)f2bf(kn);
    }
    if (tg == 0) GD[k] = __expf(blast);
    __syncthreads();
    const int g = F.lane >> 4, i = F.lane & 15, ti = F.wave >> 1;
#pragma unroll
    for (int tjj = 0; tjj < 2; ++tjj) {
        const int tj = 2 * (F.wave & 1) + tjj;
        f32x4 acc = (f32x4){0.f, 0.f, 0.f, 0.f};
        if (tj <= ti) {
#pragma unroll
            for (int s = 0; s < 4; ++s) {
                const bf16x8 af = *(const LAS bf16x8*)(qeL + (16 * ti + i) * 136 + 32 * s + 8 * g);
                const bf16x8 bfr = *(const LAS bf16x8*)(knL + (16 * tj + i) * 136 + 32 * s + 8 * g);
                acc = __builtin_amdgcn_mfma_f32_16x16x32_bf16(af, bfr, acc, 0, 0, 0);
            }
        }
#pragma unroll
        for (int r = 0; r < 4; ++r) {
            const int row = 16 * ti + 4 * g + r, col = 16 * tj + i;
            const float v = (col <= row) ? acc[r] : 0.f;
            if (row < 32) { if (col < 32) PS[row * 32 + col] = (bf16)f2bf(v); }
            else PS[1024 + (row - 32) * 64 + col] = (bf16)f2bf(v);
        }
    }
}

constexpr int L_QE = 0, L_KD = 32768, L_V = 65536, L_PS = 81920, L_GD = 94208;
static_assert(L_GD + 1024 <= 131072, "scan LDS map");
__device__ __forceinline__ int swz(int row, int cb, int rb) { return row * rb + (cb ^ ((row & 15) << 4)); }
__device__ __forceinline__ s16x4 tr_read(const LAS unsigned char* p) { return __builtin_bit_cast(s16x4, __builtin_amdgcn_ds_read_tr16_b64_v4i16((LAS v4i16_t*)p)); }
typedef __bf16 bf16x2_t __attribute__((ext_vector_type(2))); typedef float f32x2_t __attribute__((ext_vector_type(2)));
__device__ __forceinline__ unsigned cvtpk(float lo, float hi) { const f32x2_t v = {lo, hi}; const bf16x2_t b = __builtin_convertvector(v, bf16x2_t); return __builtin_bit_cast(unsigned, b); }
__device__ __forceinline__ float row16_sum(float v) {
    v += __builtin_bit_cast(float, __builtin_amdgcn_update_dpp(0, __builtin_bit_cast(int, v), 0xB1, 0xF, 0xF, true));
    v += __builtin_bit_cast(float, __builtin_amdgcn_update_dpp(0, __builtin_bit_cast(int, v), 0x4E, 0xF, 0xF, true));
    v += __builtin_bit_cast(float, __builtin_amdgcn_update_dpp(0, __builtin_bit_cast(int, v), 0x141, 0xF, 0xF, true));
    v += __builtin_bit_cast(float, __builtin_amdgcn_update_dpp(0, __builtin_bit_cast(int, v), 0x140, 0xF, 0xF, true));
    return v;
}

struct ScanPtrs { const bf16* QE; const bf16* KD; const bf16* V; const bf16* PS; const float* GD; };
struct ScanLane {
    const LAS unsigned char* qe[4][2]; const LAS unsigned char* kd[8][2]; const LAS unsigned char* v[2]; const LAS unsigned char* ps; const LAS unsigned char* gd;
    unsigned dqk, dv, dps, dgd;
    unsigned goff, yoff, soff;
};

template <int STG>
__device__ __forceinline__ void scan_stage_issue(const Frame& F, const ScanPtrs& P, const ScanLane& A, int t0, int u) {
    const int w = F.wave;
    unsigned dqk = A.dqk, dv = A.dv; asm volatile("" : "+v"(dqk), "+v"(dv));
    const char* qb = (const char*)P.QE + (size_t)t0 * 1024; const char* kb = (const char*)P.KD + (size_t)t0 * 1024; const char* vb = (const char*)P.V + (size_t)t0 * 2048;
#pragma unroll
    for (int j = 0; j < 2; ++j) {
        __builtin_amdgcn_global_load_lds((const unsigned*)(qb + (dqk + j * 32768u)), (LAS unsigned*)(F.lds + L_QE + STG * 16384 + (w + 8 * j) * 1024), 16, 0, 0);
        __builtin_amdgcn_global_load_lds((const unsigned*)(kb + (dqk + j * 32768u)), (LAS unsigned*)(F.lds + L_KD + STG * 16384 + (w + 8 * j) * 1024), 16, 0, 0);
    }
    __builtin_amdgcn_global_load_lds((const unsigned*)(vb + dv), (LAS unsigned*)(F.lds + L_V + STG * 8192 + w * 1024), 16, 0, 0);
    if (w < 6) __builtin_amdgcn_global_load_lds((const unsigned*)((const char*)P.PS + (size_t)u * 6144 + A.dps), (LAS unsigned*)(F.lds + L_PS + STG * 6144 + w * 1024), 16, 0, 0);
    else __builtin_amdgcn_global_load_lds((const unsigned*)((const char*)P.GD + (size_t)u * 512 + A.dgd), (LAS unsigned*)(F.lds + L_GD + STG * 512 + (w - 6) * 256), 4, 0, 0);
}

template <int STG>
__device__ __forceinline__ void scan_step(const Frame& F, const ScanLane& A, f32x4 (&S)[8], float gn, const bf16* G, bf16* YAB, float* SSQP, int t0) {
    const int lane = F.lane, i = lane & 15, half = F.wave >> 2;
    unsigned gq[2][4];
    {
        unsigned go = A.goff; asm volatile("" : "+v"(go));
        const char* gb = (const char*)G + (size_t)t0 * 2048;
#pragma unroll
        for (int rbl = 0; rbl < 2; ++rbl)
#pragma unroll
            for (int r = 0; r < 4; ++r) gq[rbl][r] = *(const bf16*)(gb + (go + (unsigned)((16 * rbl + r) * 2048)));
    }
    f32x4 O[2];
    O[0] = (f32x4){0.f, 0.f, 0.f, 0.f}; O[1] = (f32x4){0.f, 0.f, 0.f, 0.f};
#pragma unroll
    for (int s = 0; s < 4; ++s) {
        v4u pk; pk.x = cvtpk(S[2 * s][0], S[2 * s][1]); pk.y = cvtpk(S[2 * s][2], S[2 * s][3]); pk.z = cvtpk(S[2 * s + 1][0], S[2 * s + 1][1]); pk.w = cvtpk(S[2 * s + 1][2], S[2 * s + 1][3]);
        const bf16x8 Sf = __builtin_bit_cast(bf16x8, pk);
#pragma unroll
        for (int rbl = 0; rbl < 2; ++rbl) {
            const v2u lo = *(const LAS v2u*)(A.qe[s][0] + STG * 16384 + rbl * 4096);
            const v2u hi = *(const LAS v2u*)(A.qe[s][1] + STG * 16384 + rbl * 4096);
            v4u av; av.x = lo.x; av.y = lo.y; av.z = hi.x; av.w = hi.y;
            O[rbl] = __builtin_amdgcn_mfma_f32_16x16x32_bf16(__builtin_bit_cast(bf16x8, av), Sf, O[rbl], 0, 0, 0);
        }
    }
    bf16x8 vf[2];
#pragma unroll
    for (int ks = 0; ks < 2; ++ks) {
        const s16x4 lo = tr_read(A.v[0] + STG * 8192 + ks * 4096);
        const s16x4 hi = tr_read(A.v[1] + STG * 8192 + ks * 4096);
        vf[ks] = (bf16x8){lo[0], lo[1], lo[2], lo[3], hi[0], hi[1], hi[2], hi[3]};
    }
    if (half == 0) {
#pragma unroll
        for (int rbl = 0; rbl < 2; ++rbl) {
            const bf16x8 af = *(const LAS bf16x8*)(A.ps + STG * 6144 + rbl * 1024);
            O[rbl] = __builtin_amdgcn_mfma_f32_16x16x32_bf16(af, vf[0], O[rbl], 0, 0, 0);
        }
    } else {
#pragma unroll
        for (int rbl = 0; rbl < 2; ++rbl)
#pragma unroll
            for (int ks = 0; ks < 2; ++ks) {
                const bf16x8 af = *(const LAS bf16x8*)(A.ps + STG * 6144 + rbl * 2048 + ks * 64);
                O[rbl] = __builtin_amdgcn_mfma_f32_16x16x32_bf16(af, vf[ks], O[rbl], 0, 0, 0);
            }
    }
#pragma unroll
    for (int t = 0; t < 8; ++t) {
        const f32x4 gd4 = *(const LAS f32x4*)(A.gd + STG * 512 + t * 64);
        S[t] = S[t] * gd4;
#pragma unroll
        for (int ks = 0; ks < 2; ++ks) {
            const s16x4 lo = tr_read(A.kd[t][0] + STG * 16384 + ks * 8192);
            const s16x4 hi = tr_read(A.kd[t][1] + STG * 16384 + ks * 8192);
            const bf16x8 af = (bf16x8){lo[0], lo[1], lo[2], lo[3], hi[0], hi[1], hi[2], hi[3]};
            S[t] = __builtin_amdgcn_mfma_f32_16x16x32_bf16(af, vf[ks], S[t], 0, 0, 0);
        }
    }
    float ssq[8];
#pragma unroll
    for (int rbl = 0; rbl < 2; ++rbl)
#pragma unroll
        for (int r = 0; r < 4; ++r) ssq[4 * rbl + r] = row16_sum(O[rbl][r] * O[rbl][r]);
    {
        float mine = ssq[0];
#pragma unroll
        for (int e = 1; e < 8; ++e) mine = (i == e) ? ssq[e] : mine;
        unsigned so = A.soff; asm volatile("" : "+v"(so));
        if (i < 8) *(float*)((char*)SSQP + (size_t)t0 * 256 + so) = mine;
    }
    unsigned yo = A.yoff; asm volatile("" : "+v"(yo));
    char* yb = (char*)YAB + (size_t)t0 * 4096;
#pragma unroll
    for (int rbl = 0; rbl < 2; ++rbl)
#pragma unroll
        for (int r = 0; r < 4; ++r) {
            const float gv = bf2f(gq[rbl][r]);
            const float y = O[rbl][r] * gn * gv * sigm(gv);
            *(bf16*)(yb + (yo + (unsigned)((16 * rbl + r) * 4096))) = (bf16)cvtpk(y, 0.f);
        }
}

__device__ __forceinline__ void gla_scan(const Frame& F, const Args& a, int bhs) {
    unsigned char* ws = a.ws;
    const int slice = bhs & 3, h = (bhs >> 2) & 3, b = bhs >> 4;
    ScanPtrs P; P.QE = (const bf16*)((unsigned char*)a.out + DO_QE); P.KD = (const bf16*)((unsigned char*)a.out + DO_KD);
    P.V = (const bf16*)(ws + WS_V); P.PS = (const bf16*)(ws + WS_PS); P.GD = (const float*)(ws + WS_GD);
    const bf16* G = (const bf16*)(ws + WS_G); bf16* YAB = (bf16*)(ws + WS_YAB); float* SSQP = (float*)(ws + WS_SSQP); const float* gnw = a.in[4];
    const int w = F.wave, lane = F.lane, g = lane >> 4, i = lane & 15, q = i >> 2, p = i & 3, cg = w & 3, half = w >> 2;
    const int col0 = 256 * h + 64 * slice + 16 * cg;
    ScanLane A;
#pragma unroll
    for (int s = 0; s < 4; ++s)
#pragma unroll
        for (int hh = 0; hh < 2; ++hh) A.qe[s][hh] = F.lds + L_QE + half * 8192 + swz(i, 64 * s + 32 * hh + 8 * g, 256);
#pragma unroll
    for (int t = 0; t < 8; ++t)
#pragma unroll
        for (int hh = 0; hh < 2; ++hh) A.kd[t][hh] = F.lds + L_KD + swz(8 * g + q + 4 * hh, 32 * t + 8 * p, 256);
#pragma unroll
    for (int hh = 0; hh < 2; ++hh) A.v[hh] = F.lds + L_V + (8 * g + q + 4 * hh) * 128 + 32 * cg + 8 * p;
    A.ps = F.lds + L_PS + (half ? 2048 + i * 128 : i * 64) + 16 * g; A.gd = F.lds + L_GD + 16 * g;
    {
        const int r4 = (4 * w + (lane >> 4)) & 15;
        A.dqk = (unsigned)(((4 * w + (lane >> 4)) * 512 + 128 * h) * 2 + (((lane & 15) ^ r4) * 16));
        A.dv = (unsigned)(((8 * w + (lane >> 3)) * 1024 + 256 * h + 64 * slice) * 2 + (lane & 7) * 16);
        A.dps = (unsigned)(w * 1024 + lane * 16); A.dgd = (unsigned)(((w - 6) * 64 + lane) * 4);
        const int row0 = 32 * half + 4 * g;
        A.goff = (unsigned)((row0 * 1024 + col0 + i) * 2);
        A.yoff = (unsigned)((row0 * 2048 + col0 + i) * 2);
        A.soff = (unsigned)(((32 * half + 16 * ((i >> 2) & 1) + 4 * g + (i & 3)) * 64 + 16 * h + 4 * slice + cg) * 4);
    }
    f32x4 S[8];
#pragma unroll
    for (int t = 0; t < 8; ++t) S[t] = (f32x4){0.f, 0.f, 0.f, 0.f};
    const float gn = gnw[col0 + i];
    const int ubase = (b * 4 + h) * 32;
    scan_stage_issue<0>(F, P, A, b * SEQ, ubase);
#pragma unroll 1
    for (int c = 0; c < 32; c += 2) {
        const int t0 = b * SEQ + 64 * c;
        VM_WAIT(); __syncthreads();
        scan_stage_issue<1>(F, P, A, t0 + 64, ubase + c + 1);
        scan_step<0>(F, A, S, gn, G, YAB, SSQP, t0);
        VM_WAIT(); __syncthreads();
        if (c + 2 < 32) scan_stage_issue<0>(F, P, A, t0 + 128, ubase + c + 2);
        scan_step<1>(F, A, S, gn, G, YAB, SSQP, t0 + 64);
    }
}

namespace pg8 {
struct EpiYb {
    static constexpr bool PERM = true, AFTER_DRAIN = false, HAS_MID = false;
    const bf16_t* Z; bf16_t* YAB; const float* pb; const float* ps;
    __device__ __forceinline__ void operator()(const f32x4 (&acc)[2][2][4][2], const Unit& u, int wr, int wc, int fr, int fq) const {
        const int row0 = u.pm * BM + wr * 64 + fr, col0 = u.pn * BM + wc * 32 + 8 * fq;
#pragma unroll
        for (int bj = 0; bj < 2; ++bj) {
            const int col = col0 + bj * HALF;
            const f32x4 b0 = *(const f32x4*)(pb + col), b1 = *(const f32x4*)(pb + col + 4), s0 = *(const f32x4*)(ps + col), s1 = *(const f32x4*)(ps + col + 4);
#pragma unroll
            for (int ai = 0; ai < 2; ++ai)
#pragma unroll
                for (int m = 0; m < 4; ++m) {
                    const size_t row = (size_t)(row0 + ai * HALF + m * 16);
                    const u32x4 zw = *(const u32x4*)(Z + row * 1024 + col);
                    float z[8]; z[0] = bflo(zw.x); z[1] = bfhi(zw.x); z[2] = bflo(zw.y); z[3] = bfhi(zw.y); z[4] = bflo(zw.z); z[5] = bfhi(zw.z); z[6] = bflo(zw.w); z[7] = bfhi(zw.w);
                    f32x4 v0 = (acc[ai][bj][m][0] + b0) * s0, v1 = (acc[ai][bj][m][1] + b1) * s1;
#pragma unroll
                    for (int e = 0; e < 4; ++e) { v0[e] *= z[e] * sigm(z[e]); v1[e] *= z[4 + e] * sigm(z[4 + e]); }
                    u32x4 o; o.x = cvt_pk_bf16(v0[0], v0[1]); o.y = cvt_pk_bf16(v0[2], v0[3]); o.z = cvt_pk_bf16(v1[0], v1[1]); o.w = cvt_pk_bf16(v1[2], v1[3]);
                    *(u32x4*)(YAB + row * 2048 + 1024 + col) = o;
                    asm volatile("" ::: "memory");
                }
        }
    }
};
struct EpiMerge {
    static constexpr bool PERM = true, AFTER_DRAIN = false, HAS_MID = true;
    const bf16_t* GA; const bf16_t* GB; bf16_t* MG; const PG8_LAS float* tab;
    __device__ __forceinline__ void mid(int t, f32x4 (&acc)[2][2][4][2], const Unit& u, int wr, int wc, int fr, int fq) const {
        int zz = 0; asm volatile("" : "+v"(zz));
        {
            const int hh = t >> 2;
#pragma unroll
            for (int ai = 0; ai < 2; ++ai)
#pragma unroll
                for (int m = 0; m < 4; ++m) {
                    const int row = ai * HALF + wr * 64 + m * 16 + fr + zz;
                    const float f = tab[row * 4 + hh - 1];
#pragma unroll
                    for (int bj = 0; bj < 2; ++bj)
#pragma unroll
                        for (int n = 0; n < 2; ++n) acc[ai][bj][m][n] *= f;
                }
        }
    }
    __device__ __forceinline__ void mid_big(f32x4 (&acc)[2][2][4][2], const Unit& u, int wr, int wc, int fr, int fq) const {
        int zz = 0; asm volatile("" : "+v"(zz));
        const int row0 = u.pm * BM + wr * 64 + fr + zz, col0 = u.pn * BM + wc * 32 + 8 * fq;
#pragma unroll
        for (int ai = 0; ai < 2; ++ai)
#pragma unroll
            for (int m = 0; m < 4; ++m)
#pragma unroll
                for (int bj = 0; bj < 2; ++bj) {
                    const size_t off = (size_t)(row0 + ai * HALF + m * 16) * 1024 + col0 + bj * HALF;
                    const float r3 = tab[(ai * HALF + wr * 64 + m * 16 + fr + zz) * 4 + 3];
                    const u32x4 aw = *(const u32x4*)(GA + off), bw = *(const u32x4*)(GB + off);
                    float ga[8], gb[8];
                    ga[0] = bflo(aw.x); ga[1] = bfhi(aw.x); ga[2] = bflo(aw.y); ga[3] = bfhi(aw.y); ga[4] = bflo(aw.z); ga[5] = bfhi(aw.z); ga[6] = bflo(aw.w); ga[7] = bfhi(aw.w);
                    gb[0] = bflo(bw.x); gb[1] = bfhi(bw.x); gb[2] = bflo(bw.y); gb[3] = bfhi(bw.y); gb[4] = bflo(bw.z); gb[5] = bfhi(bw.z); gb[6] = bflo(bw.w); gb[7] = bfhi(bw.w);
#pragma unroll
                    for (int e = 0; e < 8; ++e) {
                        const float ea = expn(clampf(ga[e], -30.f, 30.f)), eb = expn(clampf(gb[e], -30.f, 30.f));
                        const float ratio = r3 * (1.0f + eb) * __builtin_amdgcn_rcpf(1.0f + ea);
                        if (e < 4) acc[ai][bj][m][0][e] *= ratio; else acc[ai][bj][m][1][e - 4] *= ratio;
                    }
                    asm volatile("" : "+v"(acc[ai][bj][m][0]), "+v"(acc[ai][bj][m][1]) :: "memory");
                    if (bj == 1) __builtin_amdgcn_sched_barrier(0);
                }
    }
    __device__ __forceinline__ void operator()(const f32x4 (&acc)[2][2][4][2], const Unit& u, int wr, int wc, int fr, int fq) const {
        int zz = 0; asm volatile("" : "+v"(zz));
        const int row0 = u.pm * BM + wr * 64 + fr + zz, col0 = u.pn * BM + wc * 32 + 8 * fq;
#pragma unroll
        for (int ai = 0; ai < 2; ++ai)
#pragma unroll
            for (int m = 0; m < 4; ++m)
#pragma unroll
                for (int bj = 0; bj < 2; ++bj) {
                    const size_t off = (size_t)(row0 + ai * HALF + m * 16) * 1024 + col0 + bj * HALF;
                    const u32x4 bw = *(const u32x4*)(GB + off);
                    float gb[8]; gb[0] = bflo(bw.x); gb[1] = bfhi(bw.x); gb[2] = bflo(bw.y); gb[3] = bfhi(bw.y); gb[4] = bflo(bw.z); gb[5] = bfhi(bw.z); gb[6] = bflo(bw.w); gb[7] = bfhi(bw.w);
                    f32x4 v0 = acc[ai][bj][m][0], v1 = acc[ai][bj][m][1];
#pragma unroll
                    for (int e = 0; e < 4; ++e) { v0[e] *= sigm(clampf(gb[e], -30.f, 30.f)); v1[e] *= sigm(clampf(gb[4 + e], -30.f, 30.f)); }
                    u32x4 o; o.x = cvt_pk_bf16(v0[0], v0[1]); o.y = cvt_pk_bf16(v0[2], v0[3]); o.z = cvt_pk_bf16(v1[0], v1[1]); o.w = cvt_pk_bf16(v1[2], v1[3]);
                    *(u32x4*)(MG + off) = o;
                    asm volatile("" ::: "memory");
                }
    }
};
struct EpiResid {
    static constexpr bool PERM = false, AFTER_DRAIN = false, HAS_MID = false;
    const float* X; float* R;
    __device__ __forceinline__ void operator()(const f32x4 (&acc)[2][2][4][2], const Unit& u, int wr, int wc, int fr, int fq) const {
        const int row0 = u.pm * BM + wr * 64 + fr, col0 = u.pn * BM + wc * 32 + 4 * fq;
#pragma unroll
        for (int ai = 0; ai < 2; ++ai)
#pragma unroll
            for (int m = 0; m < 4; ++m) { const size_t off = (size_t)(row0 + ai * HALF + m * 16) * 1024 + col0;
#pragma unroll
                for (int bj = 0; bj < 2; ++bj)
#pragma unroll
                    for (int n = 0; n < 2; ++n) { const f32x4 xv = *(const f32x4*)(X + off + bj * HALF + n * 16); *(f32x4*)(R + off + bj * HALF + n * 16) = xv * 1.189207115002721f + acc[ai][bj][m][n]; } }
    }
};
}

__device__ __forceinline__ void ln_rows(const Frame& F, float* out, const float* lw, const float* lb) {
    const int gw = F.vcu * NWAVES + F.wave, NGW = F.G * NWAVES;
    f32x4 wv[4], bv[4];
#pragma unroll
    for (int j = 0; j < 4; ++j) { wv[j] = *((const GAS f32x4*)lw + F.lane + 64 * j); bv[j] = *((const GAS f32x4*)lb + F.lane + 64 * j); }
    for (int m = gw; m < M; m += NGW) {
        GAS f32x4* xr = (GAS f32x4*)(out + (size_t)m * D) + F.lane;
        f32x4 v[4]; float s = 0.f;
#pragma unroll
        for (int j = 0; j < 4; ++j) { v[j] = xr[64 * j]; s += (v[j].x + v[j].y) + (v[j].z + v[j].w); }
        const float mean = wave_sum(s) * (1.f / D); float s2 = 0.f;
#pragma unroll
        for (int j = 0; j < 4; ++j) { v[j] = v[j] - mean; s2 += (v[j].x * v[j].x + v[j].y * v[j].y) + (v[j].z * v[j].z + v[j].w * v[j].w); }
        const float rstd = 1.f / sqrtf(wave_sum(s2) * (1.f / D) + LN_EPS);
#pragma unroll
        for (int j = 0; j < 4; ++j) xr[64 * j] = v[j] * rstd * wv[j] + bv[j];
    }
}

__global__ void __launch_bounds__(NWAVES * 64, 2) hyb_fwd(Args args) {
    extern __shared__ __attribute__((aligned(16))) unsigned char lds[];
    Frame F;
    F.lds = (LAS unsigned char*)lds;
    volatile LAS unsigned* MISC = (volatile LAS unsigned*)(F.lds + MISC_OFF);
    F.tid = threadIdx.x; F.lane = F.tid & 63; F.wave = __builtin_amdgcn_readfirstlane(F.tid >> 6);
    F.G = gridDim.x; { const int bx = blockIdx.x; F.vcu = (F.G % 8 == 0) ? (bx % 8) * (F.G / 8) + bx / 8 : bx; }
    unsigned char* ws = args.ws;
    gu32* ctl = (gu32*)(ws + WS_CTL);
    if (F.tid < 32) MISC[F.tid] = 0u;
    __syncthreads();
    XcdBarrier bar = xcd_barrier_post((unsigned*)(ctl + CW_BAR), MISC + 8);
#define GRID_BAR() xcd_barrier(bar)

#pragma unroll 1
    for (int rep = 0; rep < REP_P0; ++rep) {
    p0_prologue(F, args);
    GRID_BAR();
    }

#pragma unroll 1
    for (int rep = 0; rep < REP_P1; ++rep) {
        pg8::Gemm g{(const bf16*)((unsigned char*)args.out + DO_XB), (const bf16*)(ws + WS_WIN), 1024, 1024, 1024, 0};
        pg8::StaticOrder S; S.init(M, N1, F.G, (int)blockIdx.x);
        pg8::EpiBf16<0> E{(bf16*)(ws + WS_T0), 1024, nullptr, 1024, (size_t)(TS / 2), 1.f};
        pg8::gemm_phase<pg8::EpiBf16<0>, pg8::StaticOrder, true, true>(F.lds, g, S, E);
        GRID_BAR();
    }

#pragma unroll 1
    for (int rep = 0; rep < REP_P2A; ++rep) {
    pool_elementwise(F, (const bf16*)(ws + WS_U), (bf16*)((unsigned char*)args.out + DO_PP));
    for (int u = F.vcu; u < 1024; u += F.G) prep_unit(F, args, u);
    GRID_BAR();
    }

#pragma unroll 1
    for (int rep = 0; rep < REP_P2B; ++rep) {
    if (blockIdx.x < 128) {
        const int bx = (int)blockIdx.x, j = bx >> 3, bh = (bx & 7) * 4 + (j >> 2);
#pragma unroll 1
        for (int r2 = 0; r2 < REP_SCAN; ++r2) gla_scan(F, args, bh * 4 + (j & 3));
    } else {
        pg8::Gemm g{(const bf16*)((unsigned char*)args.out + DO_PP), (const bf16*)(ws + WS_WP), 256, 1024, 256, 256};
        pg8::StaticOrder S; S.init(M, 1024, F.G - 128, (int)blockIdx.x - 128);
        pg8::EpiYb E{(const bf16*)(ws + WS_Z), (bf16*)(ws + WS_YAB), args.in[6], args.in[7]};
        pg8::gemm_phase<pg8::EpiYb, pg8::StaticOrder, true, true>(F.lds, g, S, E);
    }
    GRID_BAR();
    }

#pragma unroll 1
    for (int rep = 0; rep < REP_P3; ++rep) {
        pg8::Gemm g{(const bf16*)(ws + WS_YAB), (const bf16*)(ws + WS_WAB), 2048, 2048, 2048, 0};
        pg8::StaticOrder S; S.init(M, 1024, F.G, (int)blockIdx.x);
        LAS float* tab = (LAS float*)(F.lds + 131072);
        {
            pg8::Unit u0; S.next(0, u0);
            if (F.tid < 256) {
                const int row = F.tid;
                const GAS f32x4* sp = (const GAS f32x4*)((const float*)(ws + WS_SSQP) + (size_t)(u0.pm * 256 + row) * 64);
                float rv[4];
#pragma unroll
                for (int hh = 0; hh < 4; ++hh) {
                    const f32x4 a0 = sp[4 * hh], a1 = sp[4 * hh + 1], a2 = sp[4 * hh + 2], a3 = sp[4 * hh + 3];
                    const float tot = ((a0.x + a0.y) + (a0.z + a0.w)) + ((a1.x + a1.y) + (a1.z + a1.w)) + ((a2.x + a2.y) + (a2.z + a2.w)) + ((a3.x + a3.y) + (a3.z + a3.w));
                    rv[hh] = __builtin_amdgcn_rsqf(tot * (1.0f / 256.0f) + RMS_EPS);
                }
                *(LAS f32x4*)(tab + row * 4) = (f32x4){rv[0] / rv[1], rv[1] / rv[2], rv[2] / rv[3], rv[3]};
            }
            __syncthreads();
        }
        pg8::EpiMerge E{(const bf16*)(ws + WS_GA), (const bf16*)(ws + WS_GB), (bf16*)(ws + WS_MG), tab};
        pg8::gemm_phase<pg8::EpiMerge, pg8::StaticOrder, true, true>(F.lds, g, S, E);
        GRID_BAR();
    }

#pragma unroll 1
    for (int rep = 0; rep < REP_P4; ++rep) {
        pg8::Gemm g{(const bf16*)(ws + WS_MG), (const bf16*)(ws + WS_WO), 1024, 1024, 1024, 0};
        pg8::StaticOrder S; S.init(M, 1024, F.G, (int)blockIdx.x);
        pg8::EpiResid E{args.in[0], args.out};
        pg8::gemm_phase<pg8::EpiResid, pg8::StaticOrder, true, true>(F.lds, g, S, E);
        GRID_BAR();
    }
#pragma unroll 1
    for (int rep = 0; rep < REP_BAR; ++rep) GRID_BAR();

    ln_rows(F, args.out, args.in[11], args.in[12]);
#undef GRID_BAR
}

extern "C" void kernel_launch(void* const* d_in, const int* in_sizes, int n_in, void* d_out, int out_size, void* d_ws, size_t ws_size, hipStream_t stream) {
    static int grid = 0;
    if (grid == 0) {
        if (n_in != 13 || in_sizes[0] != M * D || out_size != M * D || ws_size < WS_END) { fprintf(stderr, "kernel_launch: unexpected shapes / workspace (%d inputs, in0 %d, out %d, ws %zu)\n", n_in, n_in > 0 ? in_sizes[0] : -1, out_size, ws_size); grid = -1; return; }
        int dev = 0, cus = 0;
        if (hipGetDevice(&dev) != hipSuccess || hipDeviceGetAttribute(&cus, hipDeviceAttributeMultiprocessorCount, dev) != hipSuccess) { grid = -1; return; }
        if (hipFuncSetAttribute((const void*)hyb_fwd, hipFuncAttributeMaxDynamicSharedMemorySize, LDS_BYTES) != hipSuccess) { fprintf(stderr, "kernel_launch: hipFuncSetAttribute failed\n"); grid = -1; return; }
        grid = cus;
        if (grid != 256) fprintf(stderr, "kernel_launch: %d CUs (expected 256)\n", grid);
    }
    if (grid < 0) return;
    (void)hipMemsetAsync((char*)d_ws + WS_CTL, 0, CTL_ZERO_BYTES, stream);
    Args a{};
    for (int i = 0; i < 13; ++i) a.in[i] = (const float*)d_in[i];
    a.out = (float*)d_out; a.ws = (unsigned char*)d_ws;
    hipLaunchKernelGGL(hyb_fwd, dim3(grid), dim3(NWAVES * 64), LDS_BYTES, stream, a);
}
```
